# Optimizing an MI355X kernel written in HIP

```python
import jax, jax.numpy as jnp
from jax import lax
import numpy as np

D_MODEL = 4096
BATCH = 2
SEQ = 4096
DEPTH = 1

HEAD_DIM = 64
MIX_WIDTH = D_MODEL
RWKV_WIDTH = 3 * D_MODEL // 8
FOX_WIDTH = 3 * D_MODEL // 8
MEM_WIDTH = D_MODEL // 4
RWKV_HEADS = RWKV_WIDTH // HEAD_DIM
FOX_HEADS = FOX_WIDTH // HEAD_DIM
MEM_HEADS = 4
MEM_HEAD_DIM = MEM_WIDTH // MEM_HEADS
N_MEM = 256
DECAY_LORA = 128
ICLR_LORA = 128
Q_BLOCK = 128
RMS_EPS = 1e-6
GN_EPS = 64e-5

RWKV_SHIFT_SPLITS = [RWKV_WIDTH, RWKV_WIDTH, RWKV_WIDTH, DECAY_LORA, ICLR_LORA]
RWKV_SHIFT_WIDTH = 3 * RWKV_WIDTH + DECAY_LORA + ICLR_LORA
REST_SPLITS = [RWKV_WIDTH, FOX_WIDTH, FOX_WIDTH, FOX_WIDTH, FOX_HEADS, FOX_WIDTH, MEM_WIDTH, MEM_WIDTH]
REST_WIDTH = RWKV_WIDTH + 4 * FOX_WIDTH + FOX_HEADS + 2 * MEM_WIDTH
IN_WIDTH = RWKV_SHIFT_WIDTH + REST_WIDTH

kernel_name = "hymba_rwkv7_fox_memxattn_layer"


def _offsets(sizes):
    return [int(s) for s in np.cumsum(sizes)[:-1]]


def rms_norm(x, g):
    xf = x.astype(jnp.float32)
    y = xf * lax.rsqrt(jnp.mean(xf * xf, axis=-1, keepdims=True) + RMS_EPS)
    return (y * g.astype(jnp.float32)).astype(x.dtype)


def token_shift(p, mu):
    prev = jnp.pad(p, ((0, 0), (1, 0), (0, 0)))[:, :-1]
    return p + (prev - p) * mu


def rwkv7_branch(r, k, v, wl, al, w0, w_decay_up, a0, w_iclr_up, k_k, k_a, r_k, ln_x_w, ln_x_b):
    B, T, _ = r.shape
    H, N = RWKV_HEADS, HEAD_DIM
    f32 = jnp.float32
    w_pre = -jax.nn.softplus(-(w0 + jnp.tanh(wl) @ w_decay_up).astype(f32)) - 0.5
    decay = jnp.exp(-jnp.exp(w_pre))
    alpha = jax.nn.sigmoid((a0 + al @ w_iclr_up).astype(f32))
    kk = (k * k_k).astype(f32).reshape(B, T, H, N)
    kk = kk * lax.rsqrt(jnp.maximum(jnp.sum(kk * kk, axis=-1, keepdims=True), 1e-24))
    k_mod = k.astype(f32) * (1.0 + (alpha - 1.0) * k_a)

    def heads(z):
        return z.astype(f32).reshape(B, T, H, N)

    r_h, k_h, v_h, w_h, al_h = heads(r), heads(k_mod), heads(v), heads(decay), heads(alpha)
    a_h = -kk
    b_h = kk * al_h

    def step(S, inp):
        r_t, w_t, k_t, v_t, a_t, b_t = inp
        Sa = jnp.einsum('bhij,bhj->bhi', S, a_t)
        S = S * w_t[:, :, None, :] + Sa[..., None] * b_t[:, :, None, :] + v_t[..., None] * k_t[:, :, None, :]
        y_t = jnp.einsum('bhij,bhj->bhi', S, r_t)
        return S, y_t

    tm = lambda z: jnp.moveaxis(z, 1, 0)
    S0 = jnp.zeros((B, H, N, N), f32)
    _, y = lax.scan(step, S0, (tm(r_h), tm(w_h), tm(k_h), tm(v_h), tm(a_h), tm(b_h)))
    y = jnp.moveaxis(y, 0, 1)
    mean = jnp.mean(y, axis=-1, keepdims=True)
    var = jnp.mean(jnp.square(y - mean), axis=-1, keepdims=True)
    y = (y - mean) * lax.rsqrt(var + GN_EPS) * ln_x_w.astype(f32).reshape(H, N) + ln_x_b.astype(f32).reshape(H, N)
    bonus = jnp.sum(r_h * k_h * r_k.astype(f32), axis=-1, keepdims=True) * v_h
    return (y + bonus).reshape(B, T, H * N).astype(r.dtype)


def fox_attention(q, k, v, log_f):
    B, H, T, D = q.shape
    n_blk = T // Q_BLOCK
    cum = jnp.cumsum(log_f.astype(jnp.float32), axis=-1)
    kpos = jnp.arange(T)
    scale = D ** -0.5

    def one_block(i):
        start = i * Q_BLOCK
        qb = lax.dynamic_slice_in_dim(q, start, Q_BLOCK, axis=2)
        cb = lax.dynamic_slice_in_dim(cum, start, Q_BLOCK, axis=2)
        s = jnp.einsum('bhqd,bhkd->bhqk', qb, k).astype(jnp.float32) * scale + cb[..., :, None] - cum[..., None, :]
        qpos = start + jnp.arange(Q_BLOCK)
        s = jnp.where(kpos[None, :] <= qpos[:, None], s, -jnp.inf)
        p = jax.nn.softmax(s, axis=-1)
        return jnp.einsum('bhqk,bhkd->bhqd', p.astype(v.dtype), v)

    out = lax.map(one_block, jnp.arange(n_blk))
    return jnp.moveaxis(out, 0, 2).reshape(B, H, T, D)


def memory_cross_attention(q, mem, g_mem, w_mem_kv):
    B, T, _ = q.shape
    M = mem.shape[1]
    mkv = rms_norm(mem, g_mem) @ w_mem_kv
    mk, mv = jnp.split(mkv, 2, axis=-1)
    qh = q.reshape(B, T, MEM_HEADS, MEM_HEAD_DIM)
    mk = mk.reshape(B, M, MEM_HEADS, MEM_HEAD_DIM)
    mv = mv.reshape(B, M, MEM_HEADS, MEM_HEAD_DIM)
    s = jnp.einsum('bthd,bmhd->bhtm', qh, mk).astype(jnp.float32) * (MEM_HEAD_DIM ** -0.5)
    p = jax.nn.softmax(s, axis=-1)
    o = jnp.einsum('bhtm,bmhd->bthd', p.astype(mv.dtype), mv)
    return o.reshape(B, T, MEM_WIDTH)


def hybrid_layer(x, mem, g_pre, w_in, mu_rwkv, w0, w_decay_up, a0, w_iclr_up, k_k, k_a, r_k,
                 ln_x_w, ln_x_b, b_f, g_mem, w_mem_kv, w_out, g_post):
    B, T, _ = x.shape
    h = rms_norm(x, g_pre)
    p = h @ w_in
    p_shift = token_shift(p[..., :RWKV_SHIFT_WIDTH], mu_rwkv)
    r, k, v, wl, al = jnp.split(p_shift, _offsets(RWKV_SHIFT_SPLITS), axis=-1)
    g_rwkv, fq, fk, fv, f_logit, g_fox, mq, g_mq = jnp.split(p[..., RWKV_SHIFT_WIDTH:], _offsets(REST_SPLITS), axis=-1)

    y_rwkv = rwkv7_branch(r, k, v, wl, al, w0, w_decay_up, a0, w_iclr_up, k_k, k_a, r_k, ln_x_w, ln_x_b)

    to_heads = lambda z: z.reshape(B, T, FOX_HEADS, HEAD_DIM).transpose(0, 2, 1, 3)
    log_f = jax.nn.log_sigmoid((f_logit + b_f).astype(jnp.float32)).transpose(0, 2, 1)
    y_fox = fox_attention(to_heads(fq), to_heads(fk), to_heads(fv), log_f)
    y_fox = y_fox.transpose(0, 2, 1, 3).reshape(B, T, FOX_WIDTH)

    y_mem = memory_cross_attention(mq, mem, g_mem, w_mem_kv)

    y = jnp.concatenate([y_rwkv * jax.nn.silu(g_rwkv),
                         y_fox * jax.nn.silu(g_fox),
                         y_mem * jax.nn.silu(g_mq)], axis=-1)
    y = y @ w_out
    return x + rms_norm(y, g_post)


def setup_inputs(seed: int = 0) -> dict:
    key = jax.random.key(seed)
    ks = jax.random.split(key, 20)
    f32 = jnp.float32
    nrm = lambda k, shape, s: jax.random.normal(k, shape, f32) * s
    n = jnp.arange(RWKV_WIDTH, dtype=f32) / (RWKV_WIDTH - 1)
    return {
        "x": nrm(ks[0], (BATCH, SEQ, D_MODEL), 1.0),
        "mem": nrm(ks[1], (BATCH, N_MEM, D_MODEL), 1.0),
        "g_pre": 1.0 + nrm(ks[2], (DEPTH, D_MODEL), 0.02),
        "w_in": nrm(ks[3], (DEPTH, D_MODEL, IN_WIDTH), D_MODEL ** -0.5),
        "mu_rwkv": jax.random.uniform(ks[4], (DEPTH, RWKV_SHIFT_WIDTH), f32),
        "w0": (-5.5 + 5.0 * n ** 0.85)[None, :] + nrm(ks[5], (DEPTH, RWKV_WIDTH), 0.1),
        "w_decay_up": nrm(ks[6], (DEPTH, DECAY_LORA, RWKV_WIDTH), DECAY_LORA ** -0.5),
        "a0": nrm(ks[7], (DEPTH, RWKV_WIDTH), 0.1),
        "w_iclr_up": nrm(ks[8], (DEPTH, ICLR_LORA, RWKV_WIDTH), ICLR_LORA ** -0.5),
        "k_k": 0.85 + nrm(ks[9], (DEPTH, RWKV_WIDTH), 0.02),
        "k_a": 1.0 + nrm(ks[10], (DEPTH, RWKV_WIDTH), 0.02),
        "r_k": -0.04 + nrm(ks[11], (DEPTH, RWKV_HEADS, HEAD_DIM), 0.02),
        "ln_x_w": 1.0 + nrm(ks[12], (DEPTH, RWKV_WIDTH), 0.02),
        "ln_x_b": nrm(ks[13], (DEPTH, RWKV_WIDTH), 0.02),
        "b_f": 2.0 + nrm(ks[14], (DEPTH, FOX_HEADS), 0.5),
        "g_mem": 1.0 + nrm(ks[15], (DEPTH, D_MODEL), 0.02),
        "w_mem_kv": nrm(ks[16], (DEPTH, D_MODEL, 2 * MEM_WIDTH), D_MODEL ** -0.5),
        "w_out": nrm(ks[17], (DEPTH, MIX_WIDTH, D_MODEL), MIX_WIDTH ** -0.5),
        "g_post": 1.0 + nrm(ks[18], (DEPTH, D_MODEL), 0.02),
    }


def reference(x, mem, g_pre, w_in, mu_rwkv, w0, w_decay_up, a0, w_iclr_up, k_k, k_a, r_k,
              ln_x_w, ln_x_b, b_f, g_mem, w_mem_kv, w_out, g_post):
    for l in range(DEPTH):
        x = hybrid_layer(x, mem, g_pre[l], w_in[l], mu_rwkv[l], w0[l], w_decay_up[l], a0[l],
                         w_iclr_up[l], k_k[l], k_a[l], r_k[l], ln_x_w[l], ln_x_b[l], b_f[l],
                         g_mem[l], w_mem_kv[l], w_out[l], g_post[l])
    return x
```

```cpp
#include <hip/hip_cooperative_groups.h>
#include <hip/hip_runtime.h>
#include <cstdio>
#include <cstdint>
constexpr int BATCH = 2, T = 4096, DMODEL = 4096, M = BATCH * T;
constexpr int RW = 1536, FW = 1536, MW = 1024, NH = 24, HD = 64, LORA = 128;
constexpr int IN_W = 14616, NPAD = 14848;
constexpr float RMS_EPS = 1e-6f, GN_EPS = 64e-5f;
constexpr size_t MiB = 1u << 20;
constexpr size_t WS_CTL = 0, CTL_ZERO_BYTES = 65536;
constexpr size_t WS_WIN = 1 * MiB;
constexpr size_t WS_H = WS_WIN + 116 * MiB;
constexpr size_t WS_WO = WS_H + 64 * MiB;
constexpr size_t WS_WM = WS_WO + 32 * MiB;
constexpr size_t WS_WD = WS_WM + 16 * MiB;
constexpr size_t WS_MEMN = WS_WD + 1 * MiB;
constexpr size_t WS_R = WS_MEMN + 4 * MiB;
constexpr size_t WS_WA = WS_R + 144 * MiB;
constexpr size_t WS_FL = WS_WA + 8 * MiB;
constexpr size_t WS_G = WS_FL + 8 * MiB;
constexpr size_t WS_FQ = WS_G + 64 * MiB;
constexpr size_t WS_MQ = WS_FQ + 72 * MiB;
constexpr size_t WS_MK = WS_MQ + 16 * MiB;
constexpr size_t WS_A1 = WS_MK + 2 * MiB;
constexpr size_t WS_DEC = WS_A1 + 4 * MiB;
constexpr size_t WS_CUM = WS_DEC + 96 * MiB;
constexpr size_t WS_Y = WS_CUM + 1 * MiB;
constexpr size_t WS_COEF = WS_Y + 48 * MiB;
constexpr size_t WS_P = WS_COEF + 1 * MiB;
constexpr size_t WS_YC = WS_P + 16 * MiB;
constexpr size_t WS_GAME = WS_YC + 64 * MiB;
constexpr size_t WS_END = WS_GAME + 48 * MiB;
constexpr size_t WS_YO = WS_WIN;
static_assert(WS_END <= 900 * MiB, "d_ws map");
namespace pg8 {
#define PG8_LAS __attribute__((address_space(3)))
typedef unsigned short bf16_t;
typedef short bf16x8 __attribute__((ext_vector_type(8)));
typedef float f32x4 __attribute__((ext_vector_type(4)));
typedef unsigned u32x4 __attribute__((ext_vector_type(4)));
constexpr int BM = 256, BK = 64, HALF = 128, HTB = HALF * BK * 2  , STAGE_BYTES = 8 * HTB, NXCD = 8, WGM = 8;

__host__ __device__ __forceinline__ int lds_byte(int r, int c) { const int st = (r >> 4) * 2 + (c >> 5), rr = r & 15, cc = c & 31, ob = rr * 64 + cc * 2; return st * 1024 + (ob ^ (((ob >> 9) & 1) << 5)); }
__host__ __device__ __forceinline__ void stage_rc(int b, int& R, int& C) { const int st = b / 1024, sb = b % 1024, swz = sb ^ (((sb >> 9) & 1) << 5); R = (st >> 1) * 16 + swz / 64; C = (st & 1) * 32 + (swz % 64) / 2; }
__host__ __device__ __forceinline__ int perm32(int rho) { const int n = rho >> 4, i = rho & 15; return 8 * (i >> 2) + 4 * n + (i & 3); }

struct Unit { int pm, pn; };
struct Gemm { const bf16_t* A; const bf16_t* Bt; int M, N, K; };

struct StaticOrder {
    int nM, nN, nwg, G, c;
    __host__ __device__ void init(int M, int N, int G_, int c_) { nM = M / BM; nN = N / BM; nwg = nM * nN; G = G_; c = c_; }
    __host__ __device__ bool next(int i, Unit& u) const {
        const long L = (long)i * G + c; if (L >= nwg) return false;
        int wgid = (int)L; { const int q = nwg / NXCD, r = nwg % NXCD, xcd = wgid % NXCD, off = wgid / NXCD; wgid = (xcd < r ? xcd * (q + 1) : r * (q + 1) + (xcd - r) * q) + off; }
        const int nig = WGM * nN, gid = wgid / nig, fm = gid * WGM, gsz = (nM - fm) < WGM ? (nM - fm) : WGM;
        u.pm = fm + ((wgid % nig) % gsz); u.pn = (wgid % nig) / gsz; return true;
    }
    __device__ __forceinline__ void a_ready(const Unit&) const {}
    __device__ __forceinline__ void done(const Unit&) const {}
};

__device__ __forceinline__ unsigned cvt_pk_bf16(float lo, float hi) { unsigned r; asm volatile("v_cvt_pk_bf16_f32 %0, %1, %2" : "=v"(r) : "v"(lo), "v"(hi)); return r; }
typedef float f32x2 __attribute__((ext_vector_type(2)));
typedef unsigned u32x2 __attribute__((ext_vector_type(2)));
__device__ __forceinline__ float sigmoidf_(float z) { return 1.0f / (1.0f + __expf(-z)); }
__device__ __forceinline__ float bf2f(unsigned short h) { return __uint_as_float(((unsigned)h) << 16); }

struct EpiIn {
    static constexpr bool PERM = false, AFTER_DRAIN = false;
    unsigned char* ws; float qscale; int pn_off;
    __device__ __forceinline__ void operator()(const f32x4 (&acc)[2][2][4][2], const Unit& u, int wr, int wc, int fr, int fq) const {
        const int pn = u.pn + pn_off; float* fb = nullptr; bf16_t* hb = nullptr; int ldc = 1536; float sc = 1.f;
        float* R = (float*)(ws + WS_R); float* Kr = R + (size_t)M * RW; float* Vr = Kr + (size_t)M * RW; float* WA = (float*)(ws + WS_WA); float* FL = (float*)(ws + WS_FL);
        bf16_t* G = (bf16_t*)(ws + WS_G); bf16_t* FQ = (bf16_t*)(ws + WS_FQ); bf16_t* FK = FQ + (size_t)M * FW; bf16_t* FV = FK + (size_t)M * FW; bf16_t* MQh = (bf16_t*)(ws + WS_MQ);
        if (pn < 6) { fb = R + pn * 256; } else if (pn < 12) { fb = Kr + (pn - 6) * 256; } else if (pn < 18) { fb = Vr + (pn - 12) * 256; }
        else if (pn == 18) { fb = WA; ldc = 256; }
        else if (pn == 19) { fb = FL; ldc = 256; }
        else if (pn < 26) { hb = G + (pn - 20) * 256; ldc = 4096; }
        else if (pn < 32) { hb = FQ + (pn - 26) * 256; sc = qscale; }
        else if (pn < 38) { hb = FK + (pn - 32) * 256; }
        else if (pn < 44) { hb = FV + (pn - 38) * 256; }
        else if (pn < 50) { hb = G + 1536 + (pn - 44) * 256; ldc = 4096; }
        else if (pn < 54) { hb = MQh + (size_t)(pn - 50) * 8192 * 256; ldc = 256; }
        else { hb = G + 3072 + (pn - 54) * 256; ldc = 4096; }
        const int row0 = u.pm * BM + wr * 64 + fr, col0 = wc * 32 + 4 * fq;
        if (fb) {
#pragma unroll
            for (int ai = 0; ai < 2; ++ai)
#pragma unroll
                for (int m = 0; m < 4; ++m) { float* rowp = fb + (size_t)(row0 + ai * HALF + m * 16) * ldc + col0;
#pragma unroll
                    for (int bj = 0; bj < 2; ++bj)
#pragma unroll
                        for (int n = 0; n < 2; ++n) *(f32x4*)(rowp + bj * HALF + n * 16) = acc[ai][bj][m][n]; }
        } else {
#pragma unroll
            for (int ai = 0; ai < 2; ++ai)
#pragma unroll
                for (int m = 0; m < 4; ++m) { bf16_t* rowp = hb + (size_t)(row0 + ai * HALF + m * 16) * ldc + col0;
#pragma unroll
                    for (int bj = 0; bj < 2; ++bj)
#pragma unroll
                        for (int n = 0; n < 2; ++n) { const f32x4 v = acc[ai][bj][m][n] * sc; u32x2 w; w.x = cvt_pk_bf16(v[0], v[1]); w.y = cvt_pk_bf16(v[2], v[3]); *(u32x2*)(rowp + bj * HALF + n * 16) = w; } }
        }
    }
};
struct EpiTileBf16 {
    static constexpr bool PERM = false, AFTER_DRAIN = false;
    bf16_t* O; int mode;
    __device__ __forceinline__ void operator()(const f32x4 (&acc)[2][2][4][2], const Unit& u, int wr, int wc, int fr, int fq) const {
        const int tile = mode == 0 ? u.pm * 4 + u.pn : u.pn * 4 + u.pm;
        bf16_t* base = O + (size_t)tile * 65536; const int row0 = wr * 64 + fr, col0 = wc * 32 + 4 * fq;
#pragma unroll
        for (int ai = 0; ai < 2; ++ai)
#pragma unroll
            for (int m = 0; m < 4; ++m) { bf16_t* rowp = base + (size_t)(row0 + ai * HALF + m * 16) * 256 + col0;
#pragma unroll
                for (int bj = 0; bj < 2; ++bj)
#pragma unroll
                    for (int n = 0; n < 2; ++n) { const f32x4 v = acc[ai][bj][m][n]; u32x2 w; w.x = cvt_pk_bf16(v[0], v[1]); w.y = cvt_pk_bf16(v[2], v[3]); *(u32x2*)(rowp + bj * HALF + n * 16) = w; } }
    }
};
template <int MODE> struct EpiLora {
    static constexpr bool PERM = false, AFTER_DRAIN = false;
    float* O; const float* bias;
    __device__ __forceinline__ void operator()(const f32x4 (&acc)[2][2][4][2], const Unit& u, int wr, int wc, int fr, int fq) const {
        const int row0 = u.pm * BM + wr * 64 + fr, col0 = u.pn * BM + wc * 32 + 4 * fq;
#pragma unroll
        for (int bj = 0; bj < 2; ++bj)
#pragma unroll
            for (int n = 0; n < 2; ++n) { const f32x4 bv = *(const f32x4*)(bias + col0 + bj * HALF + n * 16);
#pragma unroll
                for (int ai = 0; ai < 2; ++ai)
#pragma unroll
                    for (int m = 0; m < 4; ++m) { f32x4 v = acc[ai][bj][m][n] + bv, o;
#pragma unroll
                        for (int e = 0; e < 4; ++e) { const float z = v[e];
                            const float sg = __builtin_amdgcn_rcpf(1.0f + __builtin_amdgcn_exp2f(-1.4426950408889634f * z));
                            if (MODE == 0) o[e] = __builtin_amdgcn_exp2f(-0.8750387749f * sg);
                            else o[e] = sg; }
                        *(f32x4*)(O + (size_t)(row0 + ai * HALF + m * 16) * 1536 + col0 + bj * HALF + n * 16) = o; } }
    }
};
struct EpiF32 {
    static constexpr bool PERM = false, AFTER_DRAIN = false;
    bf16_t* O; int ldc;
    __device__ __forceinline__ void operator()(const f32x4 (&acc)[2][2][4][2], const Unit& u, int wr, int wc, int fr, int fq) const {
        const int row0 = u.pm * BM + wr * 64 + fr, col0 = u.pn * BM + wc * 32 + 4 * fq;
#pragma unroll
        for (int ai = 0; ai < 2; ++ai)
#pragma unroll
            for (int m = 0; m < 4; ++m) { bf16_t* rowp = O + (size_t)(row0 + ai * HALF + m * 16) * ldc + col0;
#pragma unroll
                for (int bj = 0; bj < 2; ++bj)
#pragma unroll
                    for (int n = 0; n < 2; ++n) { const f32x4 v = acc[ai][bj][m][n]; u32x2 w; w.x = cvt_pk_bf16(v[0], v[1]); w.y = cvt_pk_bf16(v[2], v[3]); *(u32x2*)(rowp + bj * HALF + n * 16) = w; } }
    }
};
struct EpiSoftmax {
    static constexpr bool PERM = false, AFTER_DRAIN = true;
    bf16_t* P; float scale_l2;
    __device__ __forceinline__ void fused(f32x4 (&acc)[2][2][4][2], const Unit& u, int wr, int wc, int fr, int fq, PG8_LAS unsigned char* lds, int wid, int lane) const {
        PG8_LAS float* X = (PG8_LAS float*)lds;
        PG8_LAS float* Y = (PG8_LAS float*)(lds + 4096);
#pragma unroll
        for (int ai = 0; ai < 2; ++ai)
#pragma unroll
            for (int m = 0; m < 4; ++m) { float mx = -INFINITY;
#pragma unroll
                for (int bj = 0; bj < 2; ++bj)
#pragma unroll
                    for (int n = 0; n < 2; ++n) { const f32x4 x = acc[ai][bj][m][n]; mx = fmaxf(fmaxf(mx, fmaxf(x[0], x[1])), fmaxf(x[2], x[3])); }
                mx = fmaxf(mx, __shfl_xor(mx, 16)); mx = fmaxf(mx, __shfl_xor(mx, 32));
                if (fq == 0) X[(ai * HALF + wr * 64 + m * 16 + fr) * 4 + wc] = mx; }
        asm volatile("s_waitcnt lgkmcnt(0)" ::: "memory"); __builtin_amdgcn_s_barrier(); asm volatile("" ::: "memory");
#pragma unroll
        for (int ai = 0; ai < 2; ++ai)
#pragma unroll
            for (int m = 0; m < 4; ++m) { const int r = ai * HALF + wr * 64 + m * 16 + fr; const f32x4 q = *(const PG8_LAS f32x4*)(X + r * 4);
                const float mx = fmaxf(fmaxf(q[0], q[1]), fmaxf(q[2], q[3])) * scale_l2; float s = 0.f;
#pragma unroll
                for (int bj = 0; bj < 2; ++bj)
#pragma unroll
                    for (int n = 0; n < 2; ++n) { f32x4 x = acc[ai][bj][m][n];
#pragma unroll
                        for (int e = 0; e < 4; ++e) { x[e] = __builtin_amdgcn_exp2f(x[e] * scale_l2 - mx); s += x[e]; }
                        acc[ai][bj][m][n] = x; }
                s += __shfl_xor(s, 16); s += __shfl_xor(s, 32);
                if (fq == 0) Y[r * 4 + wc] = s; }
        asm volatile("s_waitcnt lgkmcnt(0)" ::: "memory"); __builtin_amdgcn_s_barrier(); asm volatile("" ::: "memory");
        bf16_t* base = P + (size_t)u.pm * 65536; const int col0 = wc * 32 + 4 * fq;
#pragma unroll
        for (int ai = 0; ai < 2; ++ai)
#pragma unroll
            for (int m = 0; m < 4; ++m) { const int r = ai * HALF + wr * 64 + m * 16 + fr; const f32x4 q = *(const PG8_LAS f32x4*)(Y + r * 4);
                const float inv = 1.0f / ((q[0] + q[1]) + (q[2] + q[3]));
#pragma unroll
                for (int bj = 0; bj < 2; ++bj)
#pragma unroll
                    for (int n = 0; n < 2; ++n) { const f32x4 v = acc[ai][bj][m][n] * inv; u32x2 w; w.x = cvt_pk_bf16(v[0], v[1]); w.y = cvt_pk_bf16(v[2], v[3]); *(u32x2*)(base + (size_t)r * 256 + col0 + bj * HALF + n * 16) = w; } }
        asm volatile("s_waitcnt lgkmcnt(0)" ::: "memory"); __builtin_amdgcn_s_barrier(); asm volatile("" ::: "memory");
    }
};
struct EpiMemOut {
    static constexpr bool PERM = false, AFTER_DRAIN = false;
    bf16_t* YC; const bf16_t* G;
    __device__ __forceinline__ void operator()(const f32x4 (&acc)[2][2][4][2], const Unit& u, int wr, int wc, int fr, int fq) const {
        const int h = u.pm >> 5, mt = u.pm & 31; const int row0 = mt * BM + wr * 64 + fr, col0 = 3072 + h * 256 + wc * 32 + 4 * fq;
#pragma unroll
        for (int ai = 0; ai < 2; ++ai)
#pragma unroll
            for (int m = 0; m < 4; ++m) { const size_t ro = (size_t)(row0 + ai * HALF + m * 16) * 4096 + col0;
#pragma unroll
                for (int bj = 0; bj < 2; ++bj)
#pragma unroll
                    for (int n = 0; n < 2; ++n) { const u32x2 gw = *(const u32x2*)(G + ro + bj * HALF + n * 16); f32x4 v = acc[ai][bj][m][n];
                        const float g0 = __uint_as_float(gw.x << 16), g1 = __uint_as_float(gw.x & 0xffff0000u), g2 = __uint_as_float(gw.y << 16), g3 = __uint_as_float(gw.y & 0xffff0000u);
                        v[0] *= g0 * sigmoidf_(g0); v[1] *= g1 * sigmoidf_(g1); v[2] *= g2 * sigmoidf_(g2); v[3] *= g3 * sigmoidf_(g3);
                        u32x2 w; w.x = cvt_pk_bf16(v[0], v[1]); w.y = cvt_pk_bf16(v[2], v[3]); *(u32x2*)(YC + ro + bj * HALF + n * 16) = w; } }
    }
};
struct QueueSched {
    unsigned* ctr; volatile PG8_LAS unsigned* ring; int count, nN, wave0;
    __device__ __forceinline__ bool leader() const { int l; asm volatile("v_mbcnt_lo_u32_b32 %0, -1, 0\n\tv_mbcnt_hi_u32_b32 %0, -1, %0" : "=v"(l)); return wave0 == 0 && l == 0; }
    __device__ __forceinline__ bool next(int i, Unit& u) const {
        if (i == 0) { if (leader()) { ring[0] = __hip_atomic_fetch_add(ctr, 1u, __ATOMIC_RELAXED, __HIP_MEMORY_SCOPE_AGENT); ring[1] = __hip_atomic_fetch_add(ctr, 1u, __ATOMIC_RELAXED, __HIP_MEMORY_SCOPE_AGENT); }
                      __syncthreads(); }
        else if (leader()) ring[(i + 1) & 3] = __hip_atomic_fetch_add(ctr, 1u, __ATOMIC_RELAXED, __HIP_MEMORY_SCOPE_AGENT);
        const int id = (int)ring[i & 3]; if (id >= count) return false;
        const int gsz = 8 * nN, gid = id / gsz, r = id % gsz; u.pm = gid * 8 + (r & 7); u.pn = r >> 3; return true; }
    __device__ __forceinline__ void a_ready(const Unit&) const {}
    __device__ __forceinline__ void done(const Unit&) const {}
};
struct ListSched {
    int first, stride, count, kind;
    int nN;
    __device__ __forceinline__ bool next(int i, Unit& u) const { const int id = first + i * stride; if (first < 0 || id >= count) return false;
        if (kind == 0) { u.pm = id / nN; u.pn = id % nN; } else { const int h = id >> 5, b = (id >> 4) & 1; u.pm = id; u.pn = 4 * b + h; } return true; }
    __device__ __forceinline__ void a_ready(const Unit&) const {}
    __device__ __forceinline__ void done(const Unit&) const {}
};
template <class Epi, class Sched, bool ALIGN_EPI = false, bool SP2 = false>
__device__ __forceinline__ void gemm_phase(PG8_LAS unsigned char* lds, const Gemm g, const Sched& S, const Epi& E, int tid_in) {
    int tid_ = tid_in; asm volatile("" : "+v"(tid_));
    const int tid = tid_, wid = __builtin_amdgcn_readfirstlane(tid >> 6), lane = tid & 63, wr = wid >> 2, wc = wid & 3, fr = lane & 15, fq = lane >> 4;
    const int K = g.K, nt = K / BK;
    unsigned voffA[2], voffB[2];
#pragma unroll
    for (int i = 0; i < 2; ++i) { int R, C; stage_rc(tid * 16 + i * 8192, R, C); const int Rb = Epi::PERM ? ((R & ~31) + perm32(R & 31)) : R;
        voffA[i] = (unsigned)(R * K + C) * 2u; voffB[i] = (unsigned)(Rb * K + C) * 2u; }
    const size_t kstep = (size_t)(BK * 2);
    const size_t hstep = (size_t)HALF * K * 2;
    const size_t tstep = 2 * hstep;
    const unsigned ldsw = (unsigned)wid * 1024u;
    const int aoff = lds_byte(wr * 64 + fr, fq * 8), boff = lds_byte(wc * 32 + fr, fq * 8);
#define PG8_SA(b, h) (((b) * 2 + (h)) * HTB)
#define PG8_SB(b, h) ((4 + (b) * 2 + (h)) * HTB)
#define PG8_STAGE(bufoff, gbase, voff) do { _Pragma("unroll") for (int _i = 0; _i < 2; ++_i) \
        __builtin_amdgcn_global_load_lds((const unsigned*)((const char*)(gbase) + (voff)[_i]), (PG8_LAS unsigned*)(lds + (bufoff) + ldsw + _i * 8192), 16, 0, 0); } while (0)
#define PG8_LDA(dst, b, h) do { _Pragma("unroll") for (int m = 0; m < 4; ++m) _Pragma("unroll") for (int k = 0; k < 2; ++k) dst[m][k] = *(const PG8_LAS bf16x8*)(lds + PG8_SA(b, h) + aoff + m * 2048 + k * 1024); } while (0)
#define PG8_LDB(dst, b, h) do { _Pragma("unroll") for (int n = 0; n < 2; ++n) _Pragma("unroll") for (int k = 0; k < 2; ++k) dst[n][k] = *(const PG8_LAS bf16x8*)(lds + PG8_SB(b, h) + boff + n * 2048 + k * 1024); } while (0)
#define PG8_MMA(ai, bj, At, Bt) do { __builtin_amdgcn_s_setprio(1); _Pragma("unroll") for (int m = 0; m < 4; ++m) _Pragma("unroll") for (int n = 0; n < 2; ++n) _Pragma("unroll") for (int k = 0; k < 2; ++k) \
        acc[ai][bj][m][n] = __builtin_amdgcn_mfma_f32_16x16x32_bf16(Bt[n][k], At[m][k], acc[ai][bj][m][n], 0, 0, 0); __builtin_amdgcn_s_setprio(0); } while (0)
#define PG8_WAIT_V(n) asm volatile("s_waitcnt vmcnt(" #n ")" ::: "memory")
#define PG8_WAIT_L(n) asm volatile("s_waitcnt lgkmcnt(" #n ")" ::: "memory")
#define PG8_BAR __builtin_amdgcn_s_barrier()
#define PG8_SCHED __builtin_amdgcn_sched_barrier(0)
    Unit cur, nxt; int ui = 0;
    if (!S.next(0, cur)) return;
    f32x4 acc[2][2][4][2];
#pragma unroll
    for (int a = 0; a < 2; ++a)
#pragma unroll
        for (int b = 0; b < 2; ++b)
#pragma unroll
            for (int m = 0; m < 4; ++m)
#pragma unroll
                for (int n = 0; n < 2; ++n) acc[a][b][m][n] = (f32x4){0.f, 0.f, 0.f, 0.f};
    bf16x8 At[4][2], B0[2][2], B1[2][2];
    const char* cA = (const char*)g.A + (size_t)cur.pm * tstep; const char* cB = (const char*)g.Bt + (size_t)cur.pn * tstep;
    S.a_ready(cur);
    if constexpr (SP2) {
        PG8_STAGE(PG8_SB(0, 0), cB, voffB); PG8_STAGE(PG8_SB(0, 1), cB + hstep, voffB); PG8_STAGE(PG8_SA(0, 0), cA, voffA); PG8_STAGE(PG8_SA(0, 1), cA + hstep, voffA);
        if (wr == 1) PG8_BAR;
        PG8_WAIT_V(2); PG8_BAR;
        PG8_STAGE(PG8_SB(1, 0), cB + kstep, voffB); PG8_STAGE(PG8_SA(1, 0), cA + kstep, voffA); PG8_STAGE(PG8_SB(1, 1), cB + hstep + kstep, voffB);
        PG8_WAIT_V(6); PG8_BAR;
    } else {
        PG8_STAGE(PG8_SB(0, 0), cB, voffB); PG8_STAGE(PG8_SA(0, 0), cA, voffA); PG8_STAGE(PG8_SB(0, 1), cB + hstep, voffB); PG8_STAGE(PG8_SA(0, 1), cA + hstep, voffA);
        if (wr == 1) PG8_BAR;
        PG8_WAIT_V(4); PG8_BAR;
        PG8_STAGE(PG8_SB(1, 0), cB + kstep, voffB); PG8_STAGE(PG8_SA(1, 0), cA + kstep, voffA); PG8_STAGE(PG8_SB(1, 1), cB + hstep + kstep, voffB);
        PG8_WAIT_V(6); PG8_BAR;
    }
    for (;;) {
        const bool has_next = S.next(ui + 1, nxt);
        const char* nA = has_next ? (const char*)g.A + (size_t)nxt.pm * tstep : cA; const char* nB = has_next ? (const char*)g.Bt + (size_t)nxt.pn * tstep : cB;
        for (int t = 0; t < nt; t += 2) {
            const bool last = (t == nt - 2);
            const char* a1 = cA + (size_t)(t + 1) * kstep;
            const char* a2 = last ? nA : cA + (size_t)(t + 2) * kstep; const char* b2 = last ? nB : cB + (size_t)(t + 2) * kstep;
            const char* a3 = a2 + kstep; const char* b3 = b2 + kstep;
            if (last && has_next) S.a_ready(nxt);
            if constexpr (SP2) {
            PG8_LDB(B0, 0, 0); PG8_LDB(B1, 0, 1); PG8_SCHED; PG8_LDA(At, 0, 0); PG8_STAGE(PG8_SA(1, 1), a1 + hstep, voffA);
            PG8_WAIT_V(8); PG8_WAIT_L(0); PG8_BAR; PG8_MMA(0, 0, At, B0); PG8_MMA(0, 1, At, B1); PG8_BAR; PG8_SCHED;
            PG8_LDA(At, 0, 1); PG8_STAGE(PG8_SB(0, 0), b2, voffB); PG8_STAGE(PG8_SB(0, 1), b2 + hstep, voffB); PG8_STAGE(PG8_SA(0, 0), a2, voffA);
            PG8_WAIT_V(8); PG8_WAIT_L(0); PG8_BAR; PG8_MMA(1, 0, At, B0); PG8_MMA(1, 1, At, B1); PG8_BAR; PG8_SCHED;
            PG8_LDB(B0, 1, 0); PG8_LDB(B1, 1, 1); PG8_SCHED; PG8_LDA(At, 1, 0); PG8_STAGE(PG8_SA(0, 1), a2 + hstep, voffA);
            PG8_WAIT_V(8); PG8_WAIT_L(0); PG8_BAR; PG8_MMA(0, 0, At, B0); PG8_MMA(0, 1, At, B1); PG8_BAR; PG8_SCHED;
            PG8_LDA(At, 1, 1); PG8_STAGE(PG8_SB(1, 0), b3, voffB); PG8_STAGE(PG8_SB(1, 1), b3 + hstep, voffB); PG8_STAGE(PG8_SA(1, 0), a3, voffA);
            PG8_WAIT_V(8); PG8_WAIT_L(0); PG8_BAR; PG8_MMA(1, 0, At, B0); PG8_MMA(1, 1, At, B1); PG8_BAR; PG8_SCHED;
            } else {
            PG8_LDB(B0, 0, 0); PG8_SCHED; PG8_LDA(At, 0, 0); PG8_STAGE(PG8_SA(1, 1), a1 + hstep, voffA);
            PG8_WAIT_L(8); PG8_BAR; PG8_WAIT_L(0); PG8_MMA(0, 0, At, B0); PG8_BAR; PG8_SCHED;
            PG8_LDB(B1, 0, 1); PG8_STAGE(PG8_SB(0, 0), b2, voffB);
            PG8_BAR; PG8_WAIT_L(0); PG8_MMA(0, 1, At, B1); PG8_BAR;
            PG8_LDA(At, 0, 1); PG8_STAGE(PG8_SA(0, 0), a2, voffA);
            PG8_BAR; PG8_WAIT_L(0); PG8_MMA(1, 0, At, B0); PG8_BAR; PG8_SCHED;
            PG8_STAGE(PG8_SB(0, 1), b2 + hstep, voffB);
            PG8_WAIT_V(6); PG8_BAR; PG8_MMA(1, 1, At, B1); PG8_BAR;
            PG8_LDB(B0, 1, 0); PG8_SCHED; PG8_LDA(At, 1, 0); PG8_STAGE(PG8_SA(0, 1), a2 + hstep, voffA);
            PG8_WAIT_L(8); PG8_BAR; PG8_WAIT_L(0); PG8_MMA(0, 0, At, B0); PG8_BAR; PG8_SCHED;
            PG8_LDB(B1, 1, 1); PG8_STAGE(PG8_SB(1, 0), b3, voffB);
            PG8_BAR; PG8_WAIT_L(0); PG8_MMA(0, 1, At, B1); PG8_BAR;
            PG8_LDA(At, 1, 1); PG8_STAGE(PG8_SA(1, 0), a3, voffA);
            PG8_BAR; PG8_WAIT_L(0); PG8_MMA(1, 0, At, B0); PG8_BAR; PG8_SCHED;
            PG8_STAGE(PG8_SB(1, 1), b3 + hstep, voffB);
            PG8_WAIT_V(6); PG8_BAR; PG8_MMA(1, 1, At, B1); PG8_BAR;
            }
        }
        if constexpr (ALIGN_EPI) { if (wr == 0) PG8_BAR; }
        if constexpr (!Epi::AFTER_DRAIN) { E(acc, cur, wr, wc, fr, fq); S.done(cur); }
        if (!has_next) break;
#pragma unroll
        for (int a = 0; a < 2; ++a)
#pragma unroll
            for (int b = 0; b < 2; ++b)
#pragma unroll
                for (int m = 0; m < 4; ++m)
#pragma unroll
                    for (int n = 0; n < 2; ++n) acc[a][b][m][n] = (f32x4){0.f, 0.f, 0.f, 0.f};
        cur = nxt; cA = nA; cB = nB; ++ui;
        if constexpr (ALIGN_EPI) { if (wr == 1) PG8_BAR; }
    }
    PG8_WAIT_V(0);
    if constexpr (!ALIGN_EPI) { if (wr == 0) PG8_BAR; }
    PG8_BAR;
    if constexpr (Epi::AFTER_DRAIN) { E.fused(acc, cur, wr, wc, fr, fq, lds, wid, lane); S.done(cur); }
#undef PG8_SA
#undef PG8_SB
#undef PG8_STAGE
#undef PG8_LDA
#undef PG8_LDB
#undef PG8_MMA
#undef PG8_WAIT_V
#undef PG8_WAIT_L
#undef PG8_BAR
#undef PG8_SCHED
}
}

#ifndef PG8_SP2
#define PG8_SP2 true
#endif
#ifndef PG8_ALIGN
#define PG8_ALIGN true
#endif
#include <hip/hip_bf16.h>
#include <cmath>
namespace attn_body {
using bf16=__hip_bfloat16;
using bf16x8=__attribute__((ext_vector_type(8)))short;
using s16x4=__attribute__((ext_vector_type(4)))short;
using f32x16=__attribute__((ext_vector_type(16)))float;
using u32x4=__attribute__((ext_vector_type(4)))unsigned;
using f32x4v=__attribute__((ext_vector_type(4)))float;
constexpr int BATCH=2,NHEAD=24,SEQ=4096,D=64,DM=NHEAD*D,OP=4096;
constexpr int NW=8,QBLK=32,QB=QBLK*NW,KVBLK=64,NQB=SEQ/QB;
constexpr int ATTN_PITCH=DM, ATTN_UNIT_ROWS=QB;
__device__ __forceinline__ int crow(int r,int hi){return (r&3)+8*(r>>2)+4*hi;}
#define SBAR() __builtin_amdgcn_sched_barrier(0)
__device__ __forceinline__ void cmask(f32x16&p0,f32x16&p1,int jb,int qrel,int hi){
  const float NEG=-INFINITY; int kb=64*jb+4*hi;
  #pragma unroll
  for(int r=0;r<16;++r){int kv=kb+(r&3)+8*(r>>2); if(kv>qrel)p0[r]=NEG; if(kv+32>qrel)p1[r]=NEG;}
}

constexpr int NSLOT=3, SLOTB=8192;
constexpr int LDS_K=0, LDS_V=NSLOT*SLOTB, LDS_WS=2*NSLOT*SLOTB, LDS_OST=LDS_WS+NW*64*4, LDS_BYTES=LDS_OST+NW*4096;
constexpr float C2=0.125f*1.4426950408889634f;
__device__ __forceinline__ void glds16(const void*gsrc,unsigned lds_dst){unsigned keep;
  asm volatile("s_mov_b32 %0, m0\n\ts_mov_b32 m0, %2\n\ts_nop 0\n\tglobal_load_lds_dwordx4 %1, off\n\ts_mov_b32 m0, %0":"=&s"(keep):"v"(gsrc),"s"(lds_dst):"memory");}
__device__ __forceinline__ float max3f(float a,float b,float c){float r;asm("v_max3_f32 %0, %1, %2, %3":"=v"(r):"v"(a),"v"(b),"v"(c));return r;}
__device__ __forceinline__ float max2f(float a,float b){float r;asm("v_max_f32_e32 %0, %1, %2":"=v"(r):"v"(a),"v"(b));return r;}
__device__ __forceinline__ float fadd_s(float a,float b){float r;asm("v_add_f32_e32 %0, %1, %2":"=v"(r):"v"(a),"v"(b));return r;}
__device__ __forceinline__ float fsub_s(float a,float b){float r;asm("v_sub_f32_e32 %0, %1, %2":"=v"(r):"v"(a),"v"(b));return r;}
typedef float f32x2_t __attribute__((ext_vector_type(2))); typedef __bf16 bf16x2_t __attribute__((ext_vector_type(2)));
__device__ __forceinline__ unsigned cvtpk_s(float lo,float hi){f32x2_t v={lo,hi};bf16x2_t b=__builtin_convertvector(v,bf16x2_t);return __builtin_bit_cast(unsigned,b);}
#define WAIT_BAR(N) asm volatile("s_waitcnt vmcnt(" #N ") lgkmcnt(0)\n\ts_barrier":::"memory")

__device__ __forceinline__ void qkt(f32x16&p0,f32x16&p1,const char*Kslot,const bf16x8*qr,int r32,int hi){
  const char*kb=Kslot+hi*1024+r32*16;
  #pragma unroll
  for(int d0=0;d0<4;++d0){
    const bf16x8 b0=*reinterpret_cast<const bf16x8*>(kb+d0*2048);
    const bf16x8 b1=*reinterpret_cast<const bf16x8*>(kb+d0*2048+512);
    {p0=__builtin_amdgcn_mfma_f32_32x32x16_bf16(b0,qr[d0],p0,0,0,0);p1=__builtin_amdgcn_mfma_f32_32x32x16_bf16(b1,qr[d0],p1,0,0,0);}}
}
typedef __attribute__((address_space(3))) const char* lds_cptr;
typedef short v4i16_t __attribute__((ext_vector_type(4)));
__device__ __forceinline__ void kload8(bf16x8*kf,lds_cptr kp){
  kf[0]=*(const __attribute__((address_space(3))) bf16x8*)(kp);      kf[1]=*(const __attribute__((address_space(3))) bf16x8*)(kp+512);
  kf[2]=*(const __attribute__((address_space(3))) bf16x8*)(kp+2048); kf[3]=*(const __attribute__((address_space(3))) bf16x8*)(kp+2560);
  kf[4]=*(const __attribute__((address_space(3))) bf16x8*)(kp+4096); kf[5]=*(const __attribute__((address_space(3))) bf16x8*)(kp+4608);
  kf[6]=*(const __attribute__((address_space(3))) bf16x8*)(kp+6144); kf[7]=*(const __attribute__((address_space(3))) bf16x8*)(kp+6656);
}
__device__ __forceinline__ void kload2(bf16x8*kf,lds_cptr kp,int j){ kf[2*j]=*(const __attribute__((address_space(3))) bf16x8*)(kp+j*2048); kf[2*j+1]=*(const __attribute__((address_space(3))) bf16x8*)(kp+j*2048+512); }
__device__ __forceinline__ s16x4 vtr(lds_cptr p){ return __builtin_bit_cast(s16x4,__builtin_amdgcn_ds_read_tr16_b64_v4i16((__attribute__((address_space(3))) v4i16_t*)p)); }
__device__ __forceinline__ float rowmax(const f32x16&p0,const f32x16&p1){
  float a=max3f(p0[0],p0[1],p1[0]),b=max3f(p0[2],p0[3],p1[1]);a=max3f(a,p1[2],p1[3]);
  #pragma unroll
  for(int r=4;r<16;r+=4){a=max3f(a,p0[r],p0[r+1]);b=max3f(b,p0[r+2],p0[r+3]);a=max3f(a,p1[r],p1[r+1]);b=max3f(b,p1[r+2],p1[r+3]);}
  const float m=max2f(a,b);
  auto rr=__builtin_amdgcn_permlane32_swap(__float_as_uint(m),__float_as_uint(m),false,false);
  return max2f(__uint_as_float(rr[0]),__uint_as_float(rr[1]));
}
__device__ __forceinline__ void pv(f32x16*o,int vb,bf16x8 pa0,bf16x8 pa1,bf16x8 pa2,bf16x8 pa3){
  #pragma unroll
  for(int d0=0;d0<2;++d0){s16x4 lo[4],hi[4];
    #pragma unroll
    for(int ks=0;ks<4;++ks){
      asm volatile("ds_read_b64_tr_b16 %0,%1 offset:%c2":"=&v"(lo[ks]):"v"(vb),"i"(d0*4096+ks*1024):"memory");
      asm volatile("ds_read_b64_tr_b16 %0,%1 offset:%c2":"=&v"(hi[ks]):"v"(vb),"i"(d0*4096+ks*1024+512):"memory");}
    asm volatile("s_waitcnt lgkmcnt(0)":::"memory");SBAR();
    #define PK(k) (bf16x8){lo[k][0],lo[k][1],lo[k][2],lo[k][3],hi[k][0],hi[k][1],hi[k][2],hi[k][3]}
    o[d0]=__builtin_amdgcn_mfma_f32_32x32x16_bf16(pa0,PK(0),o[d0],0,0,0);
    o[d0]=__builtin_amdgcn_mfma_f32_32x32x16_bf16(pa1,PK(1),o[d0],0,0,0);
    o[d0]=__builtin_amdgcn_mfma_f32_32x32x16_bf16(pa2,PK(2),o[d0],0,0,0);
    o[d0]=__builtin_amdgcn_mfma_f32_32x32x16_bf16(pa3,PK(3),o[d0],0,0,0);
    #undef PK
  }
}

#ifndef ATTN_STORE16
#define ATTN_STORE16(p,v) (*(u32x4*)(p)=(v))
#endif
template<int THRL> __device__ __forceinline__ void attn_unit(int b,int h,int qb,const bf16*Q,const bf16*__restrict__ K,const bf16*__restrict__ V,bf16*O,const bf16*Gt,const float*CUM,char*shm,int tid_in){
  int tid_=tid_in; asm volatile("":"+v"(tid_)); const int tid=tid_,lane=tid&63,r32=lane&31,hi=lane>>5; const int wid=__builtin_amdgcn_readfirstlane(tid>>6);
  const long rowbase=(long)b*SEQ; const int q0=qb*QB;
  const bf16*Qw=Q+(rowbase+q0+wid*QBLK)*DM+h*D;
  const bf16*Kh=K+rowbase*DM+h*D,*Vh=V+rowbase*DM+h*D;
  const lds_cptr shm3b=(lds_cptr)shm; const unsigned lds0=(unsigned)(uintptr_t)shm;
  float*wsf=(float*)(shm+LDS_WS)+wid*64;
  const bf16*ksrc=Kh+(long)lane*DM+wid*8;
  const bf16*vsrc=Vh+(long)(16*(wid&3)+(lane>>2))*DM+(wid>>2)*32+(lane&3)*8;
  const unsigned kdst=lds0+LDS_K+wid*1024, vdst=lds0+LDS_V+wid*1024;
  #define DMA_K(t,slot) glds16(ksrc+(long)(t)*KVBLK*DM,(unsigned)__builtin_amdgcn_readfirstlane(kdst+(slot)))
  #define DMA_V(t,slot) glds16(vsrc+(long)(t)*KVBLK*DM,(unsigned)__builtin_amdgcn_readfirstlane(vdst+(slot)))
  const int vb0=(int)(lds0+LDS_V)+((lane>>4)&1)*32+(lane&3)*8+(4*hi+((lane&15)>>2))*64;
  const char*Kbase=shm+LDS_K; bf16x8 kf[8];
  const lds_cptr shm3=(lds_cptr)shm; const lds_cptr kp0=shm3+LDS_K+hi*1024+r32*16; const lds_cptr vp0=shm3+LDS_V+((lane>>4)&1)*32+(lane&3)*8+(4*hi+((lane&15)>>2))*64;
  const int NT=(q0+QB)/KVBLK;
  DMA_K(0,0);DMA_V(0,0);DMA_K(1,SLOTB);
  const float*CUMh=CUM+(long)(b*NHEAD+h)*SEQ; __attribute__((address_space(3))) float*beta3=(__attribute__((address_space(3))) float*)(shm3b+LDS_BYTES);
  { const float c0=CUMh[q0]; float cv_[SEQ/(NW*64)];
    _Pragma("unroll") for(int i_=0;i_<SEQ/(NW*64);++i_){ const int s_=tid+i_*NW*64; cv_[i_]=(s_<q0+QB)?CUMh[s_]:0.f; }
    _Pragma("unroll") for(int i_=0;i_<SEQ/(NW*64);++i_){ const int s_=tid+i_*NW*64; if(s_<q0+QB) beta3[s_]=(c0-cv_[i_])*1.4426950408889634f; } }
  bf16x8 qr[4];
  #pragma unroll
  for(int d0=0;d0<4;++d0)qr[d0]=*reinterpret_cast<const bf16x8*>(&Qw[(long)r32*DM+d0*16+hi*8]);
  float mhat=0.f,l_reg=0.f;f32x16 o[2];o[0]=f32x16{};o[1]=f32x16{};
  const int qrel=wid*QBLK+r32;
  #define CMASK(P0,P1,t) do{int jb_=(t)-(NT-4); if(jb_>=0)cmask(P0,P1,jb_,qrel,hi);}while(0)
  bool resc=false;
  #define START(P0,P1) do{ resc=false; \
    _Pragma("unroll") for(int r=0;r<16;++r)P0[r]=__builtin_amdgcn_exp2f(P0[r]); }while(0)
  #define BLOAD(P0,P1,tn) do{ const __attribute__((address_space(3))) f32x4v* bp_=(const __attribute__((address_space(3))) f32x4v*)(beta3+(tn)*64+4*hi); \
    _Pragma("unroll") for(int g_=0;g_<4;++g_){ const f32x4v a_=bp_[2*g_], b_=bp_[8+2*g_]; \
      P0[4*g_]=a_[0];P0[4*g_+1]=a_[1];P0[4*g_+2]=a_[2];P0[4*g_+3]=a_[3]; P1[4*g_]=b_[0];P1[4*g_+1]=b_[1];P1[4*g_+2]=b_[2];P1[4*g_+3]=b_[3]; } }while(0)
  #define BSUB(P0,P1) do{ _Pragma("unroll") for(int r=0;r<16;++r){P0[r]=fsub_s(P0[r],mhat);P1[r]=fsub_s(P1[r],mhat);} }while(0)
  #define RESC() do{ if(resc){ asm volatile("s_waitcnt lgkmcnt(0)":::"memory"); \
      _Pragma("unroll") for(int d_=0;d_<2;++d_) _Pragma("unroll") for(int r=0;r<16;++r)o[d_][r]*=wsf[crow(r,hi)]; } }while(0)
  f32x16 pA0,pA1,pB0,pB1;
  int sl_prev=0,sl_cur=0,sl_next=SLOTB;
  #define ROT() do{sl_prev=sl_cur;sl_cur=sl_next;sl_next=(sl_next==(NSLOT-1)*SLOTB)?0:sl_next+SLOTB;}while(0)
  DMA_K(2,2*SLOTB);
  WAIT_BAR(3);
  mhat=beta3[q0+qrel];
  BLOAD(pA0,pA1,0); BSUB(pA0,pA1);
  qkt(pA0,pA1,Kbase,qr,r32,hi);asm volatile("s_nop 15\n\ts_nop 7":"+v"(pA0),"+v"(pA1));CMASK(pA0,pA1,0);
  START(pA0,pA1);
  BLOAD(pB0,pB1,1); BSUB(pB0,pB1);
  _Pragma("unroll") for(int r=0;r<16;++r)pA1[r]=__builtin_amdgcn_exp2f(pA1[r]);
  WAIT_BAR(0);
  DMA_K(3,0);DMA_V(1,SLOTB);
  ROT();
  kload8(kf,kp0+sl_cur);
  WAIT_BAR(2);
  s16x4 vlo[8],vhi[8]; u32x4 pw0,pw1,pw2,pw3;
  #define PKW(P,B) cvtpk_s(P[B],P[B+1])
  #define PAF(k) __builtin_bit_cast(bf16x8,pw##k)
  #define VFR(i) (bf16x8){vlo[i][0],vlo[i][1],vlo[i][2],vlo[i][3],vhi[i][0],vhi[i][1],vhi[i][2],vhi[i][3]}
  #define PIN(x) asm volatile("":"+v"(x))
  #define MX3(a,b,c) __builtin_fmaxf(__builtin_fmaxf((a),(b)),(c))
  #define GAPA(MF,A0,A1,A2,A3,W0,W1,PW) do{ MF; sacc+=A0; sacc+=A1; sacc+=A2; sacc+=A3; PIN(sacc); W0; W1; PIN(PW); SBAR(); }while(0)
  #define EX(v) __builtin_amdgcn_exp2f(v)
  #define GAPB(MF,X,B) do{ MF; X[B]=EX(X[B]); X[B+1]=EX(X[B+1]); X[B+2]=EX(X[B+2]); X[B+3]=EX(X[B+3]); PIN(X); SBAR(); }while(0)
  #define VRD(i) do{ vlo[i]=vtr(vp_+(((i)>>2)*4096+((i)&3)*1024)); vhi[i]=vtr(vp_+(((i)>>2)*4096+((i)&3)*1024+512)); }while(0)
  #define KRD(G,j) do{ if(G){ kload2(kf,kp0+sl_next,j); SBAR(); } }while(0)
  #define STEP(C0,C1,P0,P1,t,GK,GV,GL) do{ SBAR(); \
    const lds_cptr vp_=vp0+sl_prev; \
    VRD(0); SBAR(); float sacc=(P0[0]+P0[1]); \
    GAPA(C0=__builtin_amdgcn_mfma_f32_32x32x16_bf16(kf[0],qr[0],C0,0,0,0), P0[2],P0[3],P0[4],P0[5],     pw0[0]=PKW(P0,0), pw0[1]=PKW(P0,2), pw0); \
    VRD(4); SBAR(); GAPA(C1=__builtin_amdgcn_mfma_f32_32x32x16_bf16(kf[1],qr[0],C1,0,0,0), P0[6],P0[7],P0[8],P0[9],     pw0[2]=PKW(P0,4), pw0[3]=PKW(P0,6), pw0); \
    VRD(1); SBAR(); GAPA(C0=__builtin_amdgcn_mfma_f32_32x32x16_bf16(kf[2],qr[1],C0,0,0,0),   P0[10],P0[11],P0[12],P0[13], pw1[0]=PKW(P0,8), pw1[1]=PKW(P0,10), pw1); \
    VRD(5); SBAR(); GAPA(C1=__builtin_amdgcn_mfma_f32_32x32x16_bf16(kf[3],qr[1],C1,0,0,0),   P0[14],P0[15],P1[0],P1[1],   pw1[2]=PKW(P0,12),pw1[3]=PKW(P0,14), pw1); \
    VRD(2); SBAR(); GAPA(C0=__builtin_amdgcn_mfma_f32_32x32x16_bf16(kf[4],qr[2],C0,0,0,0),   P1[2],P1[3],P1[4],P1[5],     pw2[0]=PKW(P1,0), pw2[1]=PKW(P1,2), pw2); \
    VRD(6); SBAR(); GAPA(C1=__builtin_amdgcn_mfma_f32_32x32x16_bf16(kf[5],qr[2],C1,0,0,0),   P1[6],P1[7],P1[8],P1[9],     pw2[2]=PKW(P1,4), pw2[3]=PKW(P1,6), pw2); \
    VRD(3); SBAR(); GAPA(C0=__builtin_amdgcn_mfma_f32_32x32x16_bf16(kf[6],qr[3],C0,0,0,0),   P1[10],P1[11],P1[12],P1[13], pw3[0]=PKW(P1,8), pw3[1]=PKW(P1,10), pw3); \
    VRD(7); SBAR(); GAPA(C1=__builtin_amdgcn_mfma_f32_32x32x16_bf16(kf[7],qr[3],C1,0,0,0),   P1[14],P1[15],0.f,0.f,       pw3[2]=PKW(P1,12),pw3[3]=PKW(P1,14), pw3); \
    l_reg+=sacc; \
    if(GK){DMA_K((t)+3,sl_cur);} if(GV){DMA_V((t)+1,sl_next);} \
    CMASK(C0,C1,t); \
    { float a=MX3(C0[0],C0[1],C1[0]),b=MX3(C0[2],C0[3],C1[1]); a=MX3(a,C1[2],C1[3]); \
      _Pragma("unroll") for(int r=4;r<16;r+=4){a=MX3(a,C0[r],C0[r+1]);b=MX3(b,C0[r+2],C0[r+3]);a=MX3(a,C1[r],C1[r+1]);b=MX3(b,C1[r+2],C1[r+3]);} \
      float rm=__builtin_fmaxf(a,b); { auto rr=__builtin_amdgcn_permlane32_swap(__float_as_uint(rm),__float_as_uint(rm),false,false); rm=__builtin_fmaxf(__uint_as_float(rr[0]),__uint_as_float(rr[1])); } \
      resc=false; \
      if(__builtin_expect(__any(rm>(float)THRL),0)){ const float dl=__builtin_fmaxf(rm,0.f); mhat+=dl; \
        _Pragma("unroll") for(int r=0;r<16;++r){C0[r]-=dl;C1[r]-=dl;} \
        const float f=__builtin_amdgcn_exp2f(-dl); l_reg*=f; if(hi==0)wsf[r32]=f; resc=true; } } \
    SBAR(); \
    GAPB(o[0]=__builtin_amdgcn_mfma_f32_32x32x16_bf16(PAF(0),VFR(0),o[0],0,0,0), C0,0); \
    GAPB(o[1]=__builtin_amdgcn_mfma_f32_32x32x16_bf16(PAF(0),VFR(4),o[1],0,0,0), C0,4); \
    KRD(GL,0); GAPB(o[0]=__builtin_amdgcn_mfma_f32_32x32x16_bf16(PAF(1),VFR(1),o[0],0,0,0), C0,8); \
    KRD(GL,1); GAPB(o[1]=__builtin_amdgcn_mfma_f32_32x32x16_bf16(PAF(1),VFR(5),o[1],0,0,0), C0,12); \
    KRD(GL,2); GAPB(o[0]=__builtin_amdgcn_mfma_f32_32x32x16_bf16(PAF(2),VFR(2),o[0],0,0,0), C1,0); \
    KRD(GL,3); GAPB(o[1]=__builtin_amdgcn_mfma_f32_32x32x16_bf16(PAF(2),VFR(6),o[1],0,0,0), C1,4); \
    BLOAD(P0,P1,(t)+1); SBAR(); \
    GAPB(o[0]=__builtin_amdgcn_mfma_f32_32x32x16_bf16(PAF(3),VFR(3),o[0],0,0,0), C1,8); \
    GAPB(o[1]=__builtin_amdgcn_mfma_f32_32x32x16_bf16(PAF(3),VFR(7),o[1],0,0,0), C1,12); \
    BSUB(P0,P1); SBAR(); \
    }while(0)
  int t=1;
  #undef CMASK
  #define CMASK(P0,P1,t) do{}while(0)
  for(;t+5<NT;t+=2){
    STEP(pB0,pB1,pA0,pA1,t,true,true,true);     WAIT_BAR(2); RESC(); ROT();
    STEP(pA0,pA1,pB0,pB1,t+1,true,true,true);   WAIT_BAR(2); RESC(); ROT();
  }
  #undef CMASK
  #define CMASK(P0,P1,t) do{int jb_=(t)-(NT-4); if(jb_>=0)cmask(P0,P1,jb_,qrel,hi);}while(0)
  #define ENDW(tt) do{ if((tt)+3<NT){WAIT_BAR(2);} else if((tt)+2<NT){WAIT_BAR(1);} else {WAIT_BAR(0);} }while(0)
  for(;t+1<NT;t+=2){
    STEP(pB0,pB1,pA0,pA1,t,(t+3<NT),(t+1<NT),(t+1<NT));       ENDW(t);   RESC(); ROT();
    STEP(pA0,pA1,pB0,pB1,t+1,(t+4<NT),(t+2<NT),(t+2<NT));     ENDW(t+1); RESC(); ROT();
  }
  STEP(pB0,pB1,pA0,pA1,NT-1,false,false,false); RESC();
  { float sacc=pB0[0]+pB0[1]; _Pragma("unroll") for(int r=2;r<16;++r)sacc+=pB0[r]; _Pragma("unroll") for(int r=0;r<16;++r)sacc+=pB1[r]; l_reg+=sacc;
    pw0=(u32x4){PKW(pB0,0),PKW(pB0,2),PKW(pB0,4),PKW(pB0,6)};pw1=(u32x4){PKW(pB0,8),PKW(pB0,10),PKW(pB0,12),PKW(pB0,14)};pw2=(u32x4){PKW(pB1,0),PKW(pB1,2),PKW(pB1,4),PKW(pB1,6)};pw3=(u32x4){PKW(pB1,8),PKW(pB1,10),PKW(pB1,12),PKW(pB1,14)};
    SBAR(); pv(o,vb0+sl_cur,PAF(0),PAF(1),PAF(2),PAF(3)); }
  #undef PKW
  #undef PAF
  #undef VFR
  #undef PIN
  #undef MX3
  #undef GAPA
  #undef GAPB
  #undef EX
  #undef VRD
  #undef KRD
  #undef STEP
  #undef ENDW
  {auto rr=__builtin_amdgcn_permlane32_swap(__float_as_uint(l_reg),__float_as_uint(l_reg),false,false);l_reg=__uint_as_float(rr[0])+__uint_as_float(rr[1]);}
  if(hi==0)wsf[32+r32]=l_reg;asm volatile("s_waitcnt lgkmcnt(0)":::"memory");
  float rli[16];
  #pragma unroll
  for(int r=0;r<16;++r)rli[r]=__builtin_amdgcn_rcpf(wsf[32+crow(r,hi)]);
  bf16*Ow=O+(rowbase+q0+wid*QBLK)*OP+h*D; const bf16*Gw=Gt+(rowbase+q0+wid*QBLK)*OP+h*D;
  u32x4 gq_[4];
  _Pragma("unroll") for(int i=0;i<4;++i) gq_[i]=*(const u32x4*)(Gw+(long)(i*8+(lane>>3))*OP+(lane&7)*8);
  { bf16*stg=(bf16*)(shm+LDS_OST)+wid*2048;
    #pragma unroll
    for(int r=0;r<16;++r){const int orow=crow(r,hi);
      #pragma unroll
      for(int d0=0;d0<2;++d0)stg[orow*64+d0*32+r32]=__float2bfloat16(o[d0][r]*rli[r]);}
    asm volatile("s_waitcnt lgkmcnt(0)":::"memory");
    #pragma unroll
    for(int i=0;i<4;++i){const int row=i*8+(lane>>3),ch=lane&7; u32x4 v=*(const u32x4*)(stg+row*64+ch*8); const u32x4 g=gq_[i];
      _Pragma("unroll") for(int e=0;e<4;++e){ const float g0=__uint_as_float(g[e]<<16),g1=__uint_as_float(g[e]&0xffff0000u); const float x0=__uint_as_float(v[e]<<16),x1=__uint_as_float(v[e]&0xffff0000u);
        v[e]=cvtpk_s(x0*g0*__builtin_amdgcn_rcpf(1.f+__expf(-g0)), x1*g1*__builtin_amdgcn_rcpf(1.f+__expf(-g1))); }
      ATTN_STORE16(Ow+(long)row*OP+ch*8,v);} }
  asm volatile("s_waitcnt lgkmcnt(0)\n\ts_barrier":::"memory");
  #undef DMA_K
  #undef DMA_V
  #undef CMASK
  #undef START
  #undef BLOAD
  #undef BSUB
  #undef RESC
  #undef ROT
}
constexpr int ATTN_LDS_BYTES=LDS_BYTES+(SEQ+64)*4;
#undef SBAR
#undef WAIT_BAR
}

namespace cg = cooperative_groups;
constexpr int NWAVES = 8;
#ifndef MK_SINGLE
#define MK_SINGLE 1
#endif
constexpr int NPHASE = 8;
constexpr int RING_BYTES = 131072, LDS_BYTES = 163840, MISC_OFF = LDS_BYTES - 256;

#define GAS __attribute__((address_space(1)))
#define LAS __attribute__((address_space(3)))
typedef unsigned short bf16;
typedef unsigned v4u __attribute__((ext_vector_type(4)));
typedef unsigned v2u __attribute__((ext_vector_type(2)));
typedef float f32x4 __attribute__((ext_vector_type(4)));
#define LDS_WAIT() asm volatile("s_waitcnt lgkmcnt(0)" ::: "memory")
__device__ __forceinline__ unsigned f2bf(float f) { unsigned u = __builtin_bit_cast(unsigned, f); return (u + 0x7fffu + ((u >> 16) & 1u)) >> 16; }
__device__ __forceinline__ unsigned pk2(float lo, float hi) { return f2bf(lo) | (f2bf(hi) << 16); }
__device__ __forceinline__ float wave_sum(float v) {
#pragma unroll
    for (int o = 1; o < 64; o <<= 1) v += __shfl_xor(v, o);
    return v;
}
__device__ __forceinline__ float row16_sum(float x) {
    x += __builtin_bit_cast(float, __builtin_amdgcn_update_dpp(0, __builtin_bit_cast(int, x), 0xB1, 0xF, 0xF, false));
    x += __builtin_bit_cast(float, __builtin_amdgcn_update_dpp(0, __builtin_bit_cast(int, x), 0x4E, 0xF, 0xF, false));
    x += __builtin_bit_cast(float, __builtin_amdgcn_update_dpp(0, __builtin_bit_cast(int, x), 0x141, 0xF, 0xF, false));
    x += __builtin_bit_cast(float, __builtin_amdgcn_update_dpp(0, __builtin_bit_cast(int, x), 0x140, 0xF, 0xF, false));
    return x;
}

typedef GAS unsigned gu32;
#define RLX_AGENT __ATOMIC_RELAXED, __HIP_MEMORY_SCOPE_AGENT
#define XB_TMO      128
#define XB_XCNT(j)  (256  + 64 * (j))
#define XB_XSUB(j)  (1280 + 64 * (j))
#define XB_XGEN(j)  (2304 + 64 * (j))
#define XB_TOP      3328
#define XB_TOPGEN   3392
#define XCD_BAR_WORDS 3456
#define XB_SPIN_CAP (1u << 18)

__device__ __forceinline__ unsigned xb_ld(unsigned* p)              { return __hip_atomic_load(p, __ATOMIC_RELAXED, __HIP_MEMORY_SCOPE_AGENT); }
__device__ __forceinline__ unsigned xb_add(unsigned* p, unsigned v) { return __hip_atomic_fetch_add(p, v, __ATOMIC_RELAXED, __HIP_MEMORY_SCOPE_AGENT); }
__device__ __forceinline__ unsigned xb_xcc_id() { return (unsigned)__builtin_amdgcn_s_getreg((3 << 11) | 20) & 0xFu; }
#define XB_SPIN(cond, bar) do { unsigned _sp = 0; while (cond) { __builtin_amdgcn_s_sleep(1); \
    if ((++_sp & 255u) == 0u) { if (xb_ld(&(bar)[XB_TMO])) break; if (_sp > XB_SPIN_CAP) { atomicAdd(&(bar)[XB_TMO], 1u); break; } } } } while (0)

struct XcdBarrier {
    unsigned* bar; unsigned x;
    volatile LAS unsigned* st;
};

__device__ __forceinline__ XcdBarrier xcd_barrier_post(unsigned* bar, volatile LAS unsigned* st) {
    XcdBarrier b; b.bar = bar; b.x = xb_xcc_id(); b.st = st;
    if (threadIdx.x == 0) (void)xb_add(&bar[XB_XCNT(b.x)], 1u);
    return b;
}
__device__ __forceinline__ void xcd_barrier_complete(unsigned* bar, unsigned x, unsigned& nloc, unsigned& nx) {
    const unsigned G = gridDim.x * gridDim.y * gridDim.z;
    unsigned sum, cnt, mine, sp = 0u;
    for (;;) {
        sum = 0u; cnt = 0u; mine = 0u;
#pragma unroll
        for (unsigned j = 0; j < 16; ++j) { const unsigned c = xb_ld(&bar[XB_XCNT(j)]); sum += c; cnt += (c > 0u) ? 1u : 0u; mine = (j == x) ? c : mine; }
        if (sum == G) break;
        __builtin_amdgcn_s_sleep(1);
        if ((++sp & 255u) == 0u) { if (xb_ld(&bar[XB_TMO])) break; if (sp > XB_SPIN_CAP) { atomicAdd(&bar[XB_TMO], 1u); break; } }
    }
    nloc = mine > 0u ? mine : 1u; nx = cnt > 0u ? cnt : 1u;
}

__device__ __forceinline__ void xcd_barrier(const XcdBarrier& b, int tid_now) {
    asm volatile("s_waitcnt vmcnt(0)" ::: "memory");
    __syncthreads();
    if (tid_now == 0) {
        unsigned* bar = b.bar;
        __builtin_amdgcn_s_waitcnt(0);
        unsigned nloc = b.st[0], nx = b.st[1];
        if (nloc == 0u) { xcd_barrier_complete(bar, b.x, nloc, nx); b.st[0] = nloc; b.st[1] = nx; }
        const unsigned old = xb_add(&bar[XB_XSUB(b.x)], 1u);
        const unsigned gen = old / nloc;
        if (old + 1u == (gen + 1u) * nloc) {
            __builtin_amdgcn_fence(__ATOMIC_RELEASE, "agent");
            asm volatile("s_waitcnt vmcnt(0)" ::: "memory");
            const unsigned og = xb_add(&bar[XB_TOP], 1u);
            const unsigned tg = og / nx;
            if (og + 1u == (tg + 1u) * nx) xb_add(&bar[XB_TOPGEN], 1u);
            else XB_SPIN(xb_ld(&bar[XB_TOPGEN]) == tg, bar);
            __builtin_amdgcn_fence(__ATOMIC_ACQUIRE, "agent");
            xb_add(&bar[XB_XGEN(b.x)], 1u);
            asm volatile("s_waitcnt vmcnt(0)" ::: "memory");
        } else {
            XB_SPIN(xb_ld(&bar[XB_XGEN(b.x)]) == gen, bar);
            __builtin_amdgcn_fence(__ATOMIC_ACQUIRE, "agent");
            asm volatile("s_waitcnt vmcnt(0)" ::: "memory");
        }
    }
    __syncthreads();
}

__device__ __forceinline__ int lane_now() { int l; asm volatile("v_mbcnt_lo_u32_b32 %0, -1, 0\n\tv_mbcnt_hi_u32_b32 %0, -1, %0" : "=v"(l)); return l; }
struct Args { const float* in[19]; float* out; unsigned char* ws; int ph_lo, ph_hi, flags, pad; };

__device__ __forceinline__ void p0_transpose_item(const float* W, int K, int ldw, int sc0, int ncols, int nvalid, bf16* WT, int dr0, LAS float* scr, int item, int lane) {
    const int nblk = ncols / 32, kb = item / nblk, nb = item % nblk, k0 = 64 * kb, n0 = 32 * nb;
    const bool ok = (n0 + (lane & 31)) < nvalid;
    float tv[32];
    const float* wp = W + (size_t)(k0 + (lane >> 5)) * ldw + sc0 + n0 + (lane & 31);
#pragma unroll
    for (int i = 0; i < 32; ++i) tv[i] = ok ? wp[(size_t)(2 * i) * ldw] : 0.f;
#pragma unroll
    for (int i = 0; i < 32; ++i) scr[(2 * i + (lane >> 5)) * 33 + (lane & 31)] = tv[i];
    LDS_WAIT(); asm volatile("" ::: "memory");
    const int c = lane & 7;
#pragma unroll
    for (int j = 0; j < 4; ++j) { const int n = (lane >> 3) + 8 * j; const LAS float* s = scr + (8 * c) * 33 + n;
        v4u o; o.x = pk2(s[0 * 33], s[1 * 33]); o.y = pk2(s[2 * 33], s[3 * 33]); o.z = pk2(s[4 * 33], s[5 * 33]); o.w = pk2(s[6 * 33], s[7 * 33]);
        *(GAS v4u*)(WT + (size_t)(dr0 + n0 + n) * K + k0 + 8 * c) = o; }
    LDS_WAIT(); asm volatile("" ::: "memory");
}
__device__ __forceinline__ void rms_row_to_bf16(const float* xrow, const float* g, bf16* orow, int lane) {
    const GAS f32x4* xr = (const GAS f32x4*)xrow + lane; const GAS f32x4* gr = (const GAS f32x4*)g + lane;
    f32x4 v[16]; float s = 0.f;
#pragma unroll
    for (int j = 0; j < 16; ++j) { v[j] = xr[64 * j]; s += (v[j].x * v[j].x + v[j].y * v[j].y) + (v[j].z * v[j].z + v[j].w * v[j].w); }
    const float rstd = 1.0f / sqrtf(wave_sum(s) * (1.f / DMODEL) + RMS_EPS);
    GAS unsigned long long* o8 = (GAS unsigned long long*)orow + lane;
#pragma unroll
    for (int j = 0; j < 16; ++j) { const f32x4 gg = gr[64 * j]; const f32x4 y = v[j] * rstd * gg;
        o8[64 * j] = (unsigned long long)pk2(y.x, y.y) | ((unsigned long long)pk2(y.z, y.w) << 32); }
}

__device__ __forceinline__ void phase_prologue(const Args& A, LAS unsigned char* lds, int gw, int NGW, int wave, int lane) {
    unsigned char* ws = A.ws;
    LAS float* scr = (LAS float*)(lds + wave * 16384);
    const float* w_in = A.in[3]; const float* w_dec = A.in[6]; const float* w_icl = A.in[8]; const float* w_mkv = A.in[16]; const float* w_out = A.in[17];
    bf16* WinT = (bf16*)(ws + WS_WIN); bf16* WoT = (bf16*)(ws + WS_WO); bf16* WmT = (bf16*)(ws + WS_WM); bf16* WdT = (bf16*)(ws + WS_WD); bf16* WiT = WdT + 1536 * 128;
    (void)scr;
    {
        constexpr int NB_IN = NPAD / 256, I_IN = 32 * NB_IN, I_O = 32 * 16, I_M = 32 * 8, I_D = 6;
        constexpr int NITEMS = I_IN + I_O + I_M + 2 * I_D;
        const int tid = wave * 64 + lane; const int G_ = NGW / NWAVES, blk = gw / NWAVES;
        LAS float* tile = (LAS float*)lds;
        f32x4 cur[16];
#define P0_DECODE(it, SRC, LDW, NVALID, DST, KDST) do { int r_ = (it); late_n = false; \
            if (r_ < I_IN) { const int nb = r_ % NB_IN, kb = r_ / NB_IN; const int sc = nb < 19 ? 256 * nb : nb == 19 ? 11008 : nb < 44 ? 4864 + 256 * (nb - 20) : 11032 + 256 * (nb - 44); \
                SRC = w_in + (size_t)(128 * kb) * IN_W + sc; LDW = IN_W; NVALID = nb == 19 ? 24 : 256; DST = WinT + (size_t)(256 * nb) * DMODEL + 128 * kb; KDST = DMODEL; late_n = nb >= 23; } \
            else if ((r_ -= I_IN) < I_O) { const int nb = r_ % 16, kb = r_ / 16; SRC = w_out + (size_t)(128 * kb) * DMODEL + 256 * nb; LDW = DMODEL; NVALID = 256; DST = WoT + (size_t)(256 * nb) * DMODEL + 128 * kb; KDST = DMODEL; late_n = true; } \
            else if ((r_ -= I_O) < I_M) { const int nb = r_ % 8, kb = r_ / 8; SRC = w_mkv + (size_t)(128 * kb) * 2048 + 256 * nb; LDW = 2048; NVALID = 256; DST = WmT + (size_t)(256 * nb) * DMODEL + 128 * kb; KDST = DMODEL; } \
            else if ((r_ -= I_M) < I_D) { SRC = w_dec + 256 * r_; LDW = RW; NVALID = 256; DST = WdT + (size_t)(256 * r_) * LORA; KDST = LORA; } \
            else { r_ -= I_D; SRC = w_icl + 256 * r_; LDW = RW; NVALID = 256; DST = WiT + (size_t)(256 * r_) * LORA; KDST = LORA; } } while (0)
        const float* src = nullptr; int ldw = 0, nvalid = 0; bf16* dst = nullptr; int kdst = 0; bool late_n = false;
        int it = blk;
        if (it < NITEMS) { P0_DECODE(it, src, ldw, nvalid, dst, kdst);
#pragma unroll
            for (int i = 0; i < 16; ++i) cur[i] = __builtin_nontemporal_load((const f32x4*)(src + (size_t)(wave * 16 + i) * ldw + 4 * lane));     }
        while (it < NITEMS) {
            const bool zero = 4 * lane >= nvalid;
#pragma unroll
            for (int i = 0; i < 16; ++i) *(LAS f32x4*)(tile + (wave * 16 + i) * 260 + 4 * lane) = zero ? (f32x4){0.f, 0.f, 0.f, 0.f} : cur[i];
            bf16* dcur = dst; const int kcur = kdst; const bool late_c = late_n;
            const int nx = it + G_;
            if (nx < NITEMS) { P0_DECODE(nx, src, ldw, nvalid, dst, kdst);
#pragma unroll
                for (int i = 0; i < 16; ++i) cur[i] = __builtin_nontemporal_load((const f32x4*)(src + (size_t)(wave * 16 + i) * ldw + 4 * lane));     }
            LDS_WAIT(); __syncthreads();
            { const int n = wave * 32 + (lane & 31);
#pragma unroll
              for (int i = 0; i < 8; ++i) { const int c = (lane >> 5) + 2 * i; const LAS float* tp = tile + (8 * c) * 260 + n;
                  v4u o; o.x = pk2(tp[0], tp[260]); o.y = pk2(tp[2 * 260], tp[3 * 260]); o.z = pk2(tp[4 * 260], tp[5 * 260]); o.w = pk2(tp[6 * 260], tp[7 * 260]);
                  if (late_c) __builtin_nontemporal_store(o, (v4u*)(dcur + (size_t)n * kcur + 8 * c)); else *(GAS v4u*)(dcur + (size_t)n * kcur + 8 * c) = o; } }
            LDS_WAIT(); __syncthreads();
            it = nx;
        }
#undef P0_DECODE
        (void)tid;
    }
    const float* x = A.in[0]; const float* mem = A.in[1];
    bf16* H = (bf16*)(ws + WS_H); bf16* MEMN = (bf16*)(ws + WS_MEMN);
    for (int m = gw; m < M + 512; m += 2 * NGW) {
        const int m2 = m + NGW; const bool has2 = m2 < M + 512;
        const float* r1 = m < M ? x + (size_t)m * DMODEL : mem + (size_t)(m - M) * DMODEL; const float* g1 = m < M ? A.in[2] : A.in[15]; bf16* o1 = m < M ? H + (size_t)m * DMODEL : MEMN + (size_t)(m - M) * DMODEL;
        const int mb = has2 ? m2 : m;
        const float* r2 = mb < M ? x + (size_t)mb * DMODEL : mem + (size_t)(mb - M) * DMODEL; const float* g2 = mb < M ? A.in[2] : A.in[15]; bf16* o2 = mb < M ? H + (size_t)mb * DMODEL : MEMN + (size_t)(mb - M) * DMODEL;
        const GAS f32x4* x1 = (const GAS f32x4*)r1 + lane; const GAS f32x4* x2 = (const GAS f32x4*)r2 + lane;
        f32x4 va[16], vb[16]; float s1 = 0.f, s2 = 0.f;
#pragma unroll
        for (int j = 0; j < 16; ++j) va[j] = __builtin_nontemporal_load(&x1[64 * j]);
#pragma unroll
        for (int j = 0; j < 16; ++j) vb[j] = __builtin_nontemporal_load(&x2[64 * j]);
#pragma unroll
        for (int j = 0; j < 16; ++j) { s1 += (va[j].x * va[j].x + va[j].y * va[j].y) + (va[j].z * va[j].z + va[j].w * va[j].w); s2 += (vb[j].x * vb[j].x + vb[j].y * vb[j].y) + (vb[j].z * vb[j].z + vb[j].w * vb[j].w); }
        const float rs1 = 1.0f / sqrtf(wave_sum(s1) * (1.f / DMODEL) + RMS_EPS), rs2 = 1.0f / sqrtf(wave_sum(s2) * (1.f / DMODEL) + RMS_EPS);
        const GAS f32x4* ga = (const GAS f32x4*)g1 + lane; const GAS f32x4* gb = (const GAS f32x4*)g2 + lane;
        GAS unsigned long long* oa = (GAS unsigned long long*)o1 + lane; GAS unsigned long long* ob = (GAS unsigned long long*)o2 + lane;
#pragma unroll
        for (int j = 0; j < 16; ++j) { const f32x4 y = va[j] * rs1 * ga[64 * j]; oa[64 * j] = (unsigned long long)pk2(y.x, y.y) | ((unsigned long long)pk2(y.z, y.w) << 32); }
        if (has2) {
#pragma unroll
            for (int j = 0; j < 16; ++j) { const f32x4 y = vb[j] * rs2 * gb[64 * j]; ob[64 * j] = (unsigned long long)pk2(y.x, y.y) | ((unsigned long long)pk2(y.z, y.w) << 32); } }
    }
}

__device__ __forceinline__ void phase_shift_cum(const Args& A, int gtid, int NGT, int gw, int lane) {
    unsigned char* ws = A.ws;
    const float* WA = (const float*)(ws + WS_WA); const float* mu = A.in[4];
    bf16* A1 = (bf16*)(ws + WS_A1); bf16* A2 = A1 + (size_t)M * LORA;
    for (int e = gtid; e < M * 64; e += NGT) {
        const int m = e >> 6, c4 = (e & 63) * 4; const int t = m & (T - 1);
        const f32x4 cur = *(const f32x4*)(WA + (size_t)m * 256 + c4);
        const f32x4 prv = t ? *(const f32x4*)(WA + (size_t)(m - 1) * 256 + c4) : (f32x4){0.f, 0.f, 0.f, 0.f};
        const f32x4 mm = *(const f32x4*)(mu + 4608 + c4);
        f32x4 v = cur + (prv - cur) * mm;
        if (c4 < 128) { v.x = tanhf(v.x); v.y = tanhf(v.y); v.z = tanhf(v.z); v.w = tanhf(v.w);
            *(v2u*)(A1 + (size_t)m * LORA + c4) = (v2u){pk2(v.x, v.y), pk2(v.z, v.w)}; }
        else *(v2u*)(A2 + (size_t)m * LORA + (c4 - 128)) = (v2u){pk2(v.x, v.y), pk2(v.z, v.w)};
    }
    const float* FL = (const float*)(ws + WS_FL); const float* b_f = A.in[14]; float* CUM = (float*)(ws + WS_CUM);
    if (gw < BATCH * NH) {
        const int b = gw / NH, h = gw % NH; const float bf = b_f[h];
        const float* src = FL + ((size_t)b * T + lane * 64) * 256 + h; float zv[64];
#pragma unroll
        for (int i = 0; i < 64; ++i) zv[i] = src[(size_t)i * 256];
        float loc = 0.f;
#pragma unroll
        for (int i = 0; i < 64; ++i) { const float z = zv[i] + bf; loc += fminf(z, 0.f) - 0.6931471805599453f * __builtin_amdgcn_logf(1.0f + __builtin_amdgcn_exp2f(-1.4426950408889634f * fabsf(z))); zv[i] = loc; }
        float incl = loc;
#pragma unroll
        for (int o = 1; o < 64; o <<= 1) { const float n = __shfl_up(incl, o); if (lane >= o) incl += n; }
        const float off = incl - loc; float* dst = CUM + (size_t)gw * T + lane * 64;
#pragma unroll
        for (int i = 0; i < 64; i += 4) *(f32x4*)(dst + i) = (f32x4){zv[i] + off, zv[i + 1] + off, zv[i + 2] + off, zv[i + 3] + off};
    }
}

constexpr int SC_TC = 32, SC_STEP_F = 256, SC_V_OFF = SC_TC * SC_STEP_F, SC_G_OFF = SC_V_OFF + SC_TC * 32, SC_BUF_F = SC_G_OFF + 64;
constexpr int SC_YS = 68;
constexpr int SC_Y_OFF_F = 2 * SC_BUF_F;
typedef float f32x2s __attribute__((ext_vector_type(2)));
__device__ __forceinline__ float sc_fma(float a, float b, float c) { float r; asm("v_fma_f32 %0, %1, %2, %3" : "=v"(r) : "v"(a), "v"(b), "v"(c)); return r; }
__device__ __forceinline__ float sc_mul(float a, float b) { float r; asm("v_mul_f32_e32 %0, %1, %2" : "=v"(r) : "v"(a), "v"(b)); return r; }
struct ScanRegs { f32x4 r0, r1, k0, k1, w, al, e; float v0a, v1a, v0b, v1b; };
__device__ __forceinline__ void scan_load(ScanRegs& g, const unsigned char* ws, int b, int h, int half, int c, int tid) {
    const float* R = (const float*)(ws + WS_R); const float* Kr = R + (size_t)M * RW; const float* Vr = Kr + (size_t)M * RW;
    const float* DEC = (const float*)(ws + WS_DEC); const float* ALP = DEC + (size_t)M * RW; const float* GAME = (const float*)(ws + WS_GAME);
    const int jq = tid & 15, col = h * HD + 4 * jq, tl = tid >> 4, t = c * SC_TC + tl; const size_t m = (size_t)b * T + t;
    const f32x4 z4 = (f32x4){0.f, 0.f, 0.f, 0.f};
    g.r0 = *(const f32x4*)(R + m * RW + col); g.k0 = *(const f32x4*)(Kr + m * RW + col);
    g.r1 = t ? *(const f32x4*)(R + (m - 1) * RW + col) : z4; g.k1 = t ? *(const f32x4*)(Kr + (m - 1) * RW + col) : z4;
    g.w = *(const f32x4*)(DEC + m * RW + col); g.al = *(const f32x4*)(ALP + m * RW + col); g.e = *(const f32x4*)(GAME + m * RW + col);
    const int vcol = h * HD + 32 * half + jq;
    g.v0a = Vr[m * RW + vcol]; g.v0b = Vr[m * RW + vcol + 16];
    g.v1a = t ? Vr[(m - 1) * RW + vcol] : 0.f; g.v1b = t ? Vr[(m - 1) * RW + vcol + 16] : 0.f;
}
struct ScanConst { f32x4 mu_r, mu_k, kk_w, ka_w, rk_w; float mu_va, mu_vb; };
__device__ __forceinline__ void scan_store(const ScanRegs& g, const ScanConst& K, const Args& A, LAS float* buf, int b, int h, int half, int c, int tid) {
    const int jq = tid & 15, tl = tid >> 4, t = c * SC_TC + tl; const size_t m = (size_t)b * T + t;
    const f32x4 mu_r = K.mu_r, mu_k = K.mu_k, kk_w = K.kk_w, ka_w = K.ka_w, rk_w = K.rk_w; const float mu_va = K.mu_va, mu_vb = K.mu_vb;
    const f32x4 rs = g.r0 + (g.r1 - g.r0) * mu_r, ks = g.k0 + (g.k1 - g.k0) * mu_k;
    f32x4 kk = ks * kk_w;
    const float ss = row16_sum((kk.x * kk.x + kk.y * kk.y) + (kk.z * kk.z + kk.w * kk.w));
    kk = kk * __builtin_amdgcn_rsqf(fmaxf(ss, 1e-24f));
    const f32x4 km = ks * (1.0f + (g.al - 1.0f) * ka_w);
    const f32x4 rkk = rs * km * rk_w;
    const float cf = row16_sum((rkk.x + rkk.y) + (rkk.z + rkk.w));
    if (half == 0 && jq == 0) ((float*)(A.ws + WS_COEF))[m * NH + h] = cf;
    const f32x4 gt = g.e * g.w;
    f32x4 inv; inv.x = __builtin_amdgcn_rcpf(gt.x); inv.y = __builtin_amdgcn_rcpf(gt.y); inv.z = __builtin_amdgcn_rcpf(gt.z); inv.w = __builtin_amdgcn_rcpf(gt.w);
    LAS float* st = buf + tl * SC_STEP_F + 4 * jq;
    *(LAS f32x4*)(st) = -(kk * g.e); *(LAS f32x4*)(st + 64) = kk * g.al * inv; *(LAS f32x4*)(st + 128) = km * inv; *(LAS f32x4*)(st + 192) = rs * gt;
    if (tl == SC_TC - 1) *(LAS f32x4*)(buf + SC_G_OFF + 4 * jq) = gt;
    buf[SC_V_OFF + tl * 32 + jq] = g.v0a + (g.v1a - g.v0a) * mu_va; buf[SC_V_OFF + tl * 32 + jq + 16] = g.v0b + (g.v1b - g.v0b) * mu_vb;
}
__device__ __forceinline__ void scan_unit(const Args& A, LAS unsigned char* lds, int s, int tid) {
    const int bh = s >> 1, half = s & 1, b = bh / NH, h = bh % NH;
    const int wave = __builtin_amdgcn_readfirstlane(tid >> 6), lane = tid & 63;
    LAS float* buf0 = (LAS float*)lds; LAS float* buf1 = buf0 + SC_BUF_F; LAS float* yb = buf0 + SC_Y_OFF_F + wave * (SC_TC * SC_YS);
    float* Y = (float*)(A.ws + WS_Y);
    const int jq = lane & 15, rl = wave * 4 + (lane >> 4);
    float S0 = 0.f, S1 = 0.f, S2 = 0.f, S3 = 0.f;
    ScanRegs g; ScanConst K;
    { const float* mu = A.in[4]; const int col = h * HD + 4 * jq, vcol = h * HD + 32 * half + jq;
      K.mu_r = *(const f32x4*)(mu + col); K.mu_k = *(const f32x4*)(mu + RW + col); K.kk_w = *(const f32x4*)(A.in[9] + col); K.ka_w = *(const f32x4*)(A.in[10] + col); K.rk_w = *(const f32x4*)(A.in[11] + col);
      K.mu_va = mu[2 * RW + vcol]; K.mu_vb = mu[2 * RW + vcol + 16]; }
    scan_load(g, A.ws, b, h, half, 0, tid); scan_store(g, K, A, buf0, b, h, half, 0, tid);
    LDS_WAIT(); __builtin_amdgcn_s_barrier(); asm volatile("" ::: "memory");
    constexpr int NCH = T / SC_TC;
    for (int c = 0; c < NCH; ++c) {
        LAS float* cur = (c & 1) ? buf1 : buf0; LAS float* nxt = (c & 1) ? buf0 : buf1;
        if (c + 1 < NCH) scan_load(g, A.ws, b, h, half, c + 1, tid);
        {
            const LAS float* st = cur + 4 * jq; const LAS float* vp = cur + SC_V_OFF + rl;
            f32x4 a = *(const LAS f32x4*)(st), bb = *(const LAS f32x4*)(st + 64), k = *(const LAS f32x4*)(st + 128), r = *(const LAS f32x4*)(st + 192);
            float v = vp[0];
            f32x4 a1 = *(const LAS f32x4*)(st + SC_STEP_F), bb1 = *(const LAS f32x4*)(st + SC_STEP_F + 64), k1 = *(const LAS f32x4*)(st + SC_STEP_F + 128), r1 = *(const LAS f32x4*)(st + SC_STEP_F + 192);
            float v1 = vp[32];
            f32x4 pr = (f32x4){0.f, 0.f, 0.f, 0.f};
#pragma unroll
            for (int tl = 0; tl < SC_TC; ++tl) {
                float sa, yy;
                asm volatile(
                    "v_mul_f32_e32 %0, %2, %6\n\t"
                    "v_mul_f32_e32 %1, %2, %10\n\t"
                    "v_fmac_f32_e32 %0, %3, %7\n\t"
                    "v_fmac_f32_e32 %1, %3, %11\n\t"
                    "v_fmac_f32_e32 %0, %4, %8\n\t"
                    "v_fmac_f32_e32 %1, %4, %12\n\t"
                    "v_fmac_f32_e32 %0, %5, %9\n\t"
                    "v_fmac_f32_e32 %1, %5, %13\n\t"
                    "v_fmac_f32_e32 %2, %18, %14\n\t"
                    "v_add_f32_dpp %0, %0, %0 quad_perm:[1,0,3,2] row_mask:0xf bank_mask:0xf\n\t"
                    "v_fmac_f32_e32 %3, %18, %15\n\t"
                    "v_fmac_f32_e32 %4, %18, %16\n\t"
                    "v_add_f32_dpp %0, %0, %0 quad_perm:[2,3,0,1] row_mask:0xf bank_mask:0xf\n\t"
                    "v_fmac_f32_e32 %5, %18, %17\n\t"
                    "s_nop 0\n\t"
                    "v_add_f32_dpp %0, %0, %0 row_half_mirror row_mask:0xf bank_mask:0xf\n\t"
                    : "=&v"(sa), "=&v"(yy), "+v"(S0), "+v"(S1), "+v"(S2), "+v"(S3)
                    : "v"(a.x), "v"(a.y), "v"(a.z), "v"(a.w), "v"(pr.x), "v"(pr.y), "v"(pr.z), "v"(pr.w), "v"(k.x), "v"(k.y), "v"(k.z), "v"(k.w), "v"(v));
                if (tl > 0) yb[(tl - 1) * SC_YS + lane] = yy;
                const f32x4 b_now = bb; pr = r;
                a = a1; bb = bb1; k = k1; r = r1; v = v1;
                if (tl + 2 < SC_TC) { const LAS float* sn = st + (tl + 2) * SC_STEP_F;
                    a1 = *(const LAS f32x4*)(sn); bb1 = *(const LAS f32x4*)(sn + 64); k1 = *(const LAS f32x4*)(sn + 128); r1 = *(const LAS f32x4*)(sn + 192); v1 = vp[(tl + 2) * 32]; }
                __builtin_amdgcn_sched_barrier(0);
                if (tl + 2 >= SC_TC) asm volatile("s_nop 1");
                asm volatile(
                    "v_add_f32_dpp %4, %4, %4 row_mirror row_mask:0xf bank_mask:0xf\n\t"
                    "v_fmac_f32_e32 %0, %4, %5\n\t"
                    "v_fmac_f32_e32 %1, %4, %6\n\t"
                    "v_fmac_f32_e32 %2, %4, %7\n\t"
                    "v_fmac_f32_e32 %3, %4, %8\n\t"
                    : "+v"(S0), "+v"(S1), "+v"(S2), "+v"(S3), "+v"(sa)
                    : "v"(b_now.x), "v"(b_now.y), "v"(b_now.z), "v"(b_now.w));
            }
            { float yy = sc_mul(S0, pr.x); yy = sc_fma(S1, pr.y, yy); yy = sc_fma(S2, pr.z, yy); yy = sc_fma(S3, pr.w, yy); yb[(SC_TC - 1) * SC_YS + lane] = yy; }
            { const f32x4 ge = *(const LAS f32x4*)(cur + SC_G_OFF + 4 * jq); S0 = sc_mul(S0, ge.x); S1 = sc_mul(S1, ge.y); S2 = sc_mul(S2, ge.z); S3 = sc_mul(S3, ge.w); }
        }
        if (c + 1 < NCH) scan_store(g, K, A, nxt, b, h, half, c + 1, tid);
        {
            LDS_WAIT();
            const LAS f32x4* yp = (const LAS f32x4*)(yb + (lane & 31) * SC_YS + (lane >> 5) * 32);
            f32x4 s0 = yp[0] + yp[1] + (yp[2] + yp[3]), s1 = yp[4] + yp[5] + (yp[6] + yp[7]);
            f32x2s o = (f32x2s){(s0.x + s0.y) + (s0.z + s0.w), (s1.x + s1.y) + (s1.z + s1.w)};
            *(f32x2s*)(Y + ((size_t)b * T + c * SC_TC + (lane & 31)) * RW + h * HD + 32 * half + wave * 4 + (lane >> 5) * 2) = o;
        }
        LDS_WAIT(); __builtin_amdgcn_s_barrier(); asm volatile("" ::: "memory");
    }
}

__device__ __forceinline__ void phase_rwkv_out(const Args& A, int gtid, int NGT) {
    unsigned char* ws = A.ws;
    const float* Y = (const float*)(ws + WS_Y); const float* Vr = (const float*)(ws + WS_R) + (size_t)2 * M * RW; const float* COEF = (const float*)(ws + WS_COEF);
    const bf16* G = (const bf16*)(ws + WS_G); bf16* YC = (bf16*)(ws + WS_YC);
    const float* mu = A.in[4]; const float* lnw = A.in[12]; const float* lnb = A.in[13];
    for (int e0 = gtid; e0 < M * (RW / 4); e0 += 4 * NGT) {
        f32x4 y[4], v0[4], v1[4]; v2u gw[4]; float cf[4]; int mm[4], cc[4]; bool ok[4];
#pragma unroll
        for (int q = 0; q < 4; ++q) { const int e = e0 + q * NGT; ok[q] = e < M * (RW / 4); const int ee = ok[q] ? e : e0;
            const int m = ee / (RW / 4), c4 = (ee % (RW / 4)) * 4, h = c4 >> 6; const int t = m & (T - 1); mm[q] = m; cc[q] = c4;
            y[q] = __builtin_nontemporal_load((const f32x4*)(Y + (size_t)m * RW + c4));
            v0[q] = *(const f32x4*)(Vr + (size_t)m * RW + c4); v1[q] = t ? *(const f32x4*)(Vr + (size_t)(m - 1) * RW + c4) : (f32x4){0.f, 0.f, 0.f, 0.f};
            cf[q] = COEF[(size_t)m * NH + h]; gw[q] = __builtin_nontemporal_load((const v2u*)(G + (size_t)m * 4096 + c4)); }
#pragma unroll
        for (int q = 0; q < 4; ++q) { const int m = mm[q], c4 = cc[q];
            const float mean = row16_sum((y[q].x + y[q].y) + (y[q].z + y[q].w)) * (1.f / 64.f);
            const f32x4 d = y[q] - mean;
            const float var = row16_sum((d.x * d.x + d.y * d.y) + (d.z * d.z + d.w * d.w)) * (1.f / 64.f);
            const float rstd = 1.0f / sqrtf(var + GN_EPS);
            const f32x4 vs = v0[q] + (v1[q] - v0[q]) * *(const f32x4*)(mu + 2 * RW + c4);
            f32x4 o = d * rstd * *(const f32x4*)(lnw + c4) + *(const f32x4*)(lnb + c4) + cf[q] * vs;
            const float g0 = __uint_as_float(gw[q].x << 16), g1 = __uint_as_float(gw[q].x & 0xffff0000u), g2 = __uint_as_float(gw[q].y << 16), g3 = __uint_as_float(gw[q].y & 0xffff0000u);
            o.x *= g0 / (1.f + __expf(-g0)); o.y *= g1 / (1.f + __expf(-g1)); o.z *= g2 / (1.f + __expf(-g2)); o.w *= g3 / (1.f + __expf(-g3));
            if (ok[q]) *(v2u*)(YC + (size_t)m * 4096 + c4) = (v2u){pk2(o.x, o.y), pk2(o.z, o.w)}; }
    }
}
__device__ __forceinline__ void phase_final(const Args& A, int gw, int NGW, int lane) {
    const bf16* YO = (const bf16*)(A.ws + WS_YO); const float* x = A.in[0]; const float* g = A.in[18];
    for (int m = gw; m < M; m += NGW) {
        const GAS v2u* yr = (const GAS v2u*)(YO + (size_t)m * DMODEL) + lane; const GAS f32x4* xr = (const GAS f32x4*)(x + (size_t)m * DMODEL) + lane;
        const GAS f32x4* gr = (const GAS f32x4*)g + lane; GAS f32x4* orow = (GAS f32x4*)(A.out + (size_t)m * DMODEL) + lane;
        f32x4 v[16], xv[16]; float s = 0.f;
#pragma unroll
        for (int j = 0; j < 16; ++j) xv[j] = __builtin_nontemporal_load(&xr[64 * j]);
#pragma unroll
        for (int j = 0; j < 16; ++j) { const v2u q = __builtin_nontemporal_load(&yr[64 * j]); v[j] = (f32x4){__uint_as_float(q.x << 16), __uint_as_float(q.x & 0xffff0000u), __uint_as_float(q.y << 16), __uint_as_float(q.y & 0xffff0000u)}; s += (v[j].x * v[j].x + v[j].y * v[j].y) + (v[j].z * v[j].z + v[j].w * v[j].w); }
        const float rstd = 1.0f / sqrtf(wave_sum(s) * (1.f / DMODEL) + RMS_EPS);
#pragma unroll
        for (int j = 0; j < 16; ++j) __builtin_nontemporal_store(xv[j] + v[j] * rstd * gr[64 * j], &orow[64 * j]);
    }
}

__global__ void __launch_bounds__(NWAVES * 64, 2) hybrid_fwd(Args A) {
    extern __shared__ __attribute__((aligned(16))) unsigned char lds_raw[];
    LAS unsigned char* lds = (LAS unsigned char*)lds_raw;
    volatile LAS unsigned* MISC = (volatile LAS unsigned*)(lds + MISC_OFF);
    const int wave0 = __builtin_amdgcn_readfirstlane(threadIdx.x >> 6);
    const bool multi = (A.ph_hi - A.ph_lo) > 1;
    if (threadIdx.x < 16) MISC[threadIdx.x] = 0u;
    __syncthreads();
    XcdBarrier bar; bar.bar = (unsigned*)(A.ws + WS_CTL) + 4096; bar.x = 0; bar.st = MISC + 8;
    if (multi) { bar = xcd_barrier_post((unsigned*)(A.ws + WS_CTL) + 4096, MISC + 8);
                 cg::this_grid().sync(); }
#define TIDNOW (wave0 * 64 + lane_now())
#define PH_IDS int tid_ = wave0 * 64 + lane_now(); asm volatile("" : "+v"(tid_)); const int tid = tid_, lane = tid & 63, wave = __builtin_amdgcn_readfirstlane(tid >> 6); \
    const int G = gridDim.x, bx = blockIdx.x; const int vcu = (G % 8 == 0) ? (bx % 8) * (G / 8) + bx / 8 : bx; \
    const int gw = vcu * NWAVES + wave, NGW = G * NWAVES, gtid = vcu * (NWAVES * 64) + tid, NGT = G * NWAVES * 64; (void)lane; (void)gw; (void)NGW; (void)gtid; (void)NGT; (void)bx; (void)vcu; \
    unsigned char* ws = A.ws; asm volatile("" : "+s"(ws)); unsigned* ctl = (unsigned*)(ws + WS_CTL); (void)ctl; \
bf16* WinT = (bf16*)(ws + WS_WIN); bf16* H = (bf16*)(ws + WS_H); bf16* WoT = (bf16*)(ws + WS_WO); bf16* WmT = (bf16*)(ws + WS_WM); bf16* WdT = (bf16*)(ws + WS_WD); bf16* WiT = WdT + 1536 * 128; \
    bf16* MEMN = (bf16*)(ws + WS_MEMN); float* R = (float*)(ws + WS_R); float* WAp = (float*)(ws + WS_WA); float* FLp = (float*)(ws + WS_FL); \
    bf16* Gt = (bf16*)(ws + WS_G); bf16* FQ = (bf16*)(ws + WS_FQ); bf16* FK = FQ + (size_t)M * FW; bf16* FV = FK + (size_t)M * FW; bf16* MQh = (bf16*)(ws + WS_MQ); \
    bf16* MKh = (bf16*)(ws + WS_MK); bf16* MVt = MKh + 8 * 65536; bf16* A1 = (bf16*)(ws + WS_A1); bf16* A2 = A1 + (size_t)M * LORA; \
    float* DEC = (float*)(ws + WS_DEC); float* ALP = DEC + (size_t)M * RW; bf16* Pm = (bf16*)(ws + WS_P); bf16* YC = (bf16*)(ws + WS_YC); bf16* YO = (bf16*)(ws + WS_YO);
    const int lo = A.ph_lo, hi = A.ph_hi;
#ifndef PHMASK
#define PHMASK 0xFFF
#endif
#define IN(k) (((PHMASK >> (k)) & 1) && lo <= (k) && (k) < hi)
#define SEAM(k) do { if (IN(k) && IN((k) + 1)) { xcd_barrier(bar, TIDNOW); } } while (0)
    if (IN(0)) { PH_IDS phase_prologue(A, lds, gw, NGW, wave, lane); __syncthreads(); }
    SEAM(0);
    if (IN(1)) { PH_IDS
        { pg8::Gemm g{H, WinT, M, 5888, DMODEL}; pg8::StaticOrder S; S.init(M, 5888, G, bx);
          pg8::EpiIn E{ws, attn_body::C2, 0};
          pg8::gemm_phase<pg8::EpiIn, pg8::StaticOrder, PG8_ALIGN, PG8_SP2>(lds, g, S, E, TIDNOW); }
        { const int e = (G == 256) ? bx - 224 : bx;
          pg8::ListSched S{(e >= 0 && e < 8) ? e : -1, 1 << 20, 8, 0, 4};
          pg8::Gemm g{MEMN, WmT, 512, 1024, DMODEL}; pg8::EpiTileBf16 E{MKh, 0};
          pg8::gemm_phase<pg8::EpiTileBf16, pg8::ListSched, PG8_ALIGN, PG8_SP2>(lds, g, S, E, TIDNOW);
          pg8::ListSched S2{(e >= 8 && e < 16) ? e - 8 : -1, 1 << 20, 8, 0, 2};
          pg8::Gemm g2{WmT + (size_t)1024 * DMODEL, MEMN, 1024, 512, DMODEL}; pg8::EpiTileBf16 E2{MVt, 1};
          pg8::gemm_phase<pg8::EpiTileBf16, pg8::ListSched, PG8_ALIGN, PG8_SP2>(lds, g2, S2, E2, TIDNOW); }
    }
    SEAM(1);
    if (IN(2)) { PH_IDS phase_shift_cum(A, gtid, NGT, gw, lane); }
    SEAM(2);
    if (IN(3)) { PH_IDS
        { pg8::Gemm g{A1, WdT, M, RW, LORA}; pg8::ListSched S{bx, G, 192, 0, 6}; pg8::EpiLora<0> E{DEC, A.in[5]};
          pg8::gemm_phase<pg8::EpiLora<0>, pg8::ListSched, PG8_ALIGN, PG8_SP2>(lds, g, S, E, TIDNOW); }
        {
            __builtin_amdgcn_fence(__ATOMIC_SEQ_CST, "workgroup"); asm volatile("s_waitcnt vmcnt(0)" ::: "memory"); __syncthreads();
            float* GAME = (float*)(ws + WS_GAME); const int t2 = TIDNOW;
            for (int u = bx; u < 192; u += G) { const int pm = u / 6, pn = u % 6;
                for (int i = 0; i < 4; i += 2) { const size_t base = (size_t)(pm * 256 + (t2 >> 6) * 32) * RW + pn * 256 + (t2 & 63) + 64 * i;
                    float wv[32], wu[32];
#pragma unroll
                    for (int t = 0; t < 32; ++t) { wv[t] = __hip_atomic_load(DEC + base + (size_t)t * RW, __ATOMIC_RELAXED, __HIP_MEMORY_SCOPE_AGENT); wu[t] = __hip_atomic_load(DEC + base + 64 + (size_t)t * RW, __ATOMIC_RELAXED, __HIP_MEMORY_SCOPE_AGENT); }
                    float gq = 1.f, gu = 1.f;
#pragma unroll
                    for (int t = 0; t < 32; ++t) { GAME[base + (size_t)t * RW] = gq; gq *= wv[t]; GAME[base + 64 + (size_t)t * RW] = gu; gu *= wu[t]; } } }
        }
        { pg8::Gemm g{A2, WiT, M, RW, LORA}; pg8::ListSched S{(G == 256) ? (bx >= 192 ? bx - 192 : -1) : bx, (G == 256) ? 64 : G, 192, 0, 6}; pg8::EpiLora<1> E{ALP, A.in[7]};
          pg8::gemm_phase<pg8::EpiLora<1>, pg8::ListSched, PG8_ALIGN, PG8_SP2>(lds, g, S, E, TIDNOW); }
    }
    SEAM(3);
    if (IN(4)) { PH_IDS
        int sidx = -1;
        if (G >= 256) { if ((vcu & 31) < 12 && vcu < 256) sidx = (vcu >> 5) * 12 + (vcu & 31); }
        if (!(A.flags & 1)) {
            if (sidx >= 0) scan_unit(A, lds, sidx, tid);
            else if (G < 256) { for (int s = bx; s < 96; s += G) scan_unit(A, lds, s, tid); }
        }
        if (!(A.flags & 2)) {
            __syncthreads();
            pg8::Gemm g{H, WinT + (size_t)5888 * DMODEL, M, 8960, DMODEL}; pg8::QueueSched S{ctl + 128, (volatile LAS unsigned*)(MISC + 16), 32 * 35, 35, wave0};
            pg8::EpiIn E{ws, attn_body::C2, 23};
            pg8::gemm_phase<pg8::EpiIn, pg8::QueueSched, PG8_ALIGN, PG8_SP2>(lds, g, S, E, TIDNOW);
        }
    }
    SEAM(4);
    if (IN(5)) { PH_IDS
        phase_rwkv_out(A, gtid, NGT);
        __syncthreads();
        for (int id = vcu; id < 128; id += G) {
            { pg8::Gemm g{MQh, MKh, 4 * M, 2048, 256}; pg8::ListSched S{id, 1 << 20, 128, 1, 0}; pg8::EpiSoftmax E{Pm, 0.0625f * 1.4426950408889634f};
              pg8::gemm_phase<pg8::EpiSoftmax, pg8::ListSched, false, PG8_SP2>(lds, g, S, E, TIDNOW); }
            __builtin_amdgcn_fence(__ATOMIC_SEQ_CST, "workgroup"); asm volatile("s_waitcnt vmcnt(0)" ::: "memory"); __syncthreads();
            { pg8::Gemm g{Pm, MVt, 4 * M, 2048, 256}; pg8::ListSched S{id, 1 << 20, 128, 1, 0}; pg8::EpiMemOut E{YC, Gt};
              pg8::gemm_phase<pg8::EpiMemOut, pg8::ListSched, false, PG8_SP2>(lds, g, S, E, TIDNOW); }
            __syncthreads();
        }
        const float* CUM = (const float*)(ws + WS_CUM);
        if (TIDNOW == 0) MISC[0] = atomicAdd(ctl + 64, 1u);
        __syncthreads(); int item = (int)MISC[0]; __syncthreads();
        while (item < 768) {
            unsigned nxt_item = 0u; const bool lead = (TIDNOW == 0);
            if (lead) nxt_item = __hip_atomic_fetch_add(ctl + 64, 1u, __ATOMIC_RELAXED, __HIP_MEMORY_SCOPE_AGENT);
            const int qb = 15 - item / 48, bh = item % 48;
            attn_body::attn_unit<8>(bh / NH, bh % NH, qb, (const attn_body::bf16*)FQ, (const attn_body::bf16*)FK, (const attn_body::bf16*)FV, (attn_body::bf16*)(YC + RW), (const attn_body::bf16*)(Gt + RW), CUM, (char*)lds_raw, TIDNOW);
            if (lead) MISC[0] = nxt_item;
            __syncthreads(); item = (int)MISC[0]; __syncthreads();
        }
    }
    SEAM(5);
    if (IN(6)) { PH_IDS pg8::Gemm g{YC, WoT, M, DMODEL, DMODEL}; pg8::StaticOrder S; S.init(M, DMODEL, G, bx); pg8::EpiF32 E{YO, DMODEL};
        pg8::gemm_phase<pg8::EpiF32, pg8::StaticOrder, PG8_ALIGN, PG8_SP2>(lds, g, S, E, TIDNOW); }
    SEAM(6);
    if (IN(7)) { PH_IDS phase_final(A, gw, NGW, lane); }
#undef IN
#undef SEAM
}

extern "C" void kernel_launch(void* const* d_in, const int* in_sizes, int n_in, void* d_out, int out_size, void* d_ws, size_t ws_size, hipStream_t stream) {
    static int grid = 0;
    if (grid == 0) {
        if (n_in != 19 || out_size != M * DMODEL || ws_size < WS_END) { fprintf(stderr, "kernel_launch: unexpected shapes (n_in %d out %d ws %zu)\n", n_in, out_size, ws_size); grid = -1; return; }
        int dev = 0, cus = 0, per_cu = 0;
        hipGetDevice(&dev); hipDeviceGetAttribute(&cus, hipDeviceAttributeMultiprocessorCount, dev);
        if (hipFuncSetAttribute((const void*)hybrid_fwd, hipFuncAttributeMaxDynamicSharedMemorySize, LDS_BYTES) != hipSuccess) { fprintf(stderr, "kernel_launch: hipFuncSetAttribute failed\n"); grid = -1; return; }
        if (hipOccupancyMaxActiveBlocksPerMultiprocessor(&per_cu, (const void*)hybrid_fwd, NWAVES * 64, LDS_BYTES) != hipSuccess || per_cu < 1) { fprintf(stderr, "kernel_launch: occupancy query says %d\n", per_cu); per_cu = 1; }
        (void)hipGetLastError();
        grid = cus * per_cu;
    }
    if (grid < 0) return;
    hipMemsetAsync((char*)d_ws + WS_CTL, 0, CTL_ZERO_BYTES, stream);
    Args a{};
    for (int i = 0; i < 19; ++i) a.in[i] = (const float*)d_in[i];
    a.out = (float*)d_out; a.ws = (unsigned char*)d_ws;
#if MK_SINGLE
    a.ph_lo = 0; a.ph_hi = NPHASE;
    void* args[] = {&a};
    hipError_t e = hipLaunchCooperativeKernel((const void*)hybrid_fwd, dim3(grid), dim3(NWAVES * 64), args, LDS_BYTES, stream);
    if (e != hipSuccess) fprintf(stderr, "cooperative launch failed: %s (grid %d)\n", hipGetErrorString(e), grid);
#else
    for (int p = 0; p < NPHASE; ++p) { a.ph_lo = p; a.ph_hi = p + 1; hipLaunchKernelGGL(hybrid_fwd, dim3(grid), dim3(NWAVES * 64), LDS_BYTES, stream, a);
#ifndef PROBE_FLAGS
#define PROBE_FLAGS 0
#endif
#ifdef PROBE_PHASES
        if ((PROBE_PHASES >> p) & 1) { hipMemsetAsync((char*)d_ws + WS_CTL, 0, CTL_ZERO_BYTES, stream); a.flags = PROBE_FLAGS; hipLaunchKernelGGL(hybrid_fwd, dim3(grid), dim3(NWAVES * 64), LDS_BYTES, stream, a); a.flags = 0; }
#endif
    }
#endif
}
```

```cpp
#include <hip/hip_cooperative_groups.h>
#include <hip/hip_runtime.h>
#include <cstdio>
#include <cstdint>
constexpr int BATCH = 2, T = 4096, DMODEL = 4096, M = BATCH * T;
constexpr int RW = 1536, FW = 1536, MW = 1024, NH = 24, HD = 64, LORA = 128;
constexpr int IN_W = 14616, NPAD = 14848;
constexpr float RMS_EPS = 1e-6f, GN_EPS = 64e-5f;
constexpr size_t MiB = 1u << 20;
constexpr size_t WS_CTL = 0, CTL_ZERO_BYTES = 65536;
constexpr size_t WS_WIN = 1 * MiB;
constexpr size_t WS_H = WS_WIN + 116 * MiB;
constexpr size_t WS_WO = WS_H + 64 * MiB;
constexpr size_t WS_WM = WS_WO + 32 * MiB;
constexpr size_t WS_WD = WS_WM + 16 * MiB;
constexpr size_t WS_MEMN = WS_WD + 1 * MiB;
constexpr size_t WS_R = WS_MEMN + 4 * MiB;
constexpr size_t WS_WA = WS_R + 144 * MiB;
constexpr size_t WS_FL = WS_WA + 8 * MiB;
constexpr size_t WS_G = WS_FL + 8 * MiB;
constexpr size_t WS_FQ = WS_G + 64 * MiB;
constexpr size_t WS_MQ = WS_FQ + 72 * MiB;
constexpr size_t WS_MK = WS_MQ + 16 * MiB;
constexpr size_t WS_A1 = WS_MK + 2 * MiB;
constexpr size_t WS_DEC = WS_A1 + 4 * MiB;
constexpr size_t WS_CUM = WS_DEC + 96 * MiB;
constexpr size_t WS_Y = WS_CUM + 1 * MiB;
constexpr size_t WS_COEF = WS_Y + 48 * MiB;
constexpr size_t WS_P = WS_COEF + 1 * MiB;
constexpr size_t WS_YC = WS_P + 16 * MiB;
constexpr size_t WS_GAME = WS_YC + 64 * MiB;
constexpr size_t WS_END = WS_GAME + 48 * MiB;
constexpr size_t WS_YO = WS_WIN;
static_assert(WS_END <= 900 * MiB, "d_ws map");
namespace pg8 {
#define PG8_LAS __attribute__((address_space(3)))
typedef unsigned short bf16_t;
typedef short bf16x8 __attribute__((ext_vector_type(8)));
typedef float f32x4 __attribute__((ext_vector_type(4)));
typedef unsigned u32x4 __attribute__((ext_vector_type(4)));
constexpr int BM = 256, BK = 64, HALF = 128, HTB = HALF * BK * 2  , STAGE_BYTES = 8 * HTB, NXCD = 8, WGM = 8;

__host__ __device__ __forceinline__ int lds_byte(int r, int c) { const int st = (r >> 4) * 2 + (c >> 5), rr = r & 15, cc = c & 31, ob = rr * 64 + cc * 2; return st * 1024 + (ob ^ (((ob >> 9) & 1) << 5)); }
__host__ __device__ __forceinline__ void stage_rc(int b, int& R, int& C) { const int st = b / 1024, sb = b % 1024, swz = sb ^ (((sb >> 9) & 1) << 5); R = (st >> 1) * 16 + swz / 64; C = (st & 1) * 32 + (swz % 64) / 2; }
__host__ __device__ __forceinline__ int perm32(int rho) { const int n = rho >> 4, i = rho & 15; return 8 * (i >> 2) + 4 * n + (i & 3); }

struct Unit { int pm, pn; };
struct Gemm { const bf16_t* A; const bf16_t* Bt; int M, N, K; };

struct StaticOrder {
    int nM, nN, nwg, G, c;
    __host__ __device__ void init(int M, int N, int G_, int c_) { nM = M / BM; nN = N / BM; nwg = nM * nN; G = G_; c = c_; }
    __host__ __device__ bool next(int i, Unit& u) const {
        const long L = (long)i * G + c; if (L >= nwg) return false;
        int wgid = (int)L; { const int q = nwg / NXCD, r = nwg % NXCD, xcd = wgid % NXCD, off = wgid / NXCD; wgid = (xcd < r ? xcd * (q + 1) : r * (q + 1) + (xcd - r) * q) + off; }
        const int nig = WGM * nN, gid = wgid / nig, fm = gid * WGM, gsz = (nM - fm) < WGM ? (nM - fm) : WGM;
        u.pm = fm + ((wgid % nig) % gsz); u.pn = (wgid % nig) / gsz; return true;
    }
    __device__ __forceinline__ void a_ready(const Unit&) const {}
    __device__ __forceinline__ void done(const Unit&) const {}
};

__device__ __forceinline__ unsigned cvt_pk_bf16(float lo, float hi) { unsigned r; asm volatile("v_cvt_pk_bf16_f32 %0, %1, %2" : "=v"(r) : "v"(lo), "v"(hi)); return r; }
typedef float f32x2 __attribute__((ext_vector_type(2)));
typedef unsigned u32x2 __attribute__((ext_vector_type(2)));
__device__ __forceinline__ float sigmoidf_(float z) { return 1.0f / (1.0f + __expf(-z)); }
__device__ __forceinline__ float bf2f(unsigned short h) { return __uint_as_float(((unsigned)h) << 16); }

struct EpiIn {
    static constexpr bool PERM = false, AFTER_DRAIN = false;
    unsigned char* ws; float qscale; int pn_off;
    __device__ __forceinline__ void operator()(const f32x4 (&acc)[2][2][4][2], const Unit& u, int wr, int wc, int fr, int fq) const {
        const int pn = u.pn + pn_off; float* fb = nullptr; bf16_t* hb = nullptr; int ldc = 1536; float sc = 1.f;
        float* R = (float*)(ws + WS_R); float* Kr = R + (size_t)M * RW; float* Vr = Kr + (size_t)M * RW; float* WA = (float*)(ws + WS_WA); float* FL = (float*)(ws + WS_FL);
        bf16_t* G = (bf16_t*)(ws + WS_G); bf16_t* FQ = (bf16_t*)(ws + WS_FQ); bf16_t* FK = FQ + (size_t)M * FW; bf16_t* FV = FK + (size_t)M * FW; bf16_t* MQh = (bf16_t*)(ws + WS_MQ);
        if (pn < 6) { fb = R + pn * 256; } else if (pn < 12) { fb = Kr + (pn - 6) * 256; } else if (pn < 18) { fb = Vr + (pn - 12) * 256; }
        else if (pn == 18) { fb = WA; ldc = 256; }
        else if (pn == 19) { fb = FL; ldc = 256; }
        else if (pn < 26) { hb = G + (pn - 20) * 256; ldc = 4096; }
        else if (pn < 32) { hb = FQ + (pn - 26) * 256; sc = qscale; }
        else if (pn < 38) { hb = FK + (pn - 32) * 256; }
        else if (pn < 44) { hb = FV + (pn - 38) * 256; }
        else if (pn < 50) { hb = G + 1536 + (pn - 44) * 256; ldc = 4096; }
        else if (pn < 54) { hb = MQh + (size_t)(pn - 50) * 8192 * 256; ldc = 256; }
        else { hb = G + 3072 + (pn - 54) * 256; ldc = 4096; }
        const int row0 = u.pm * BM + wr * 64 + fr, col0 = wc * 32 + 4 * fq;
        if (fb) {
#pragma unroll
            for (int ai = 0; ai < 2; ++ai)
#pragma unroll
                for (int m = 0; m < 4; ++m) { float* rowp = fb + (size_t)(row0 + ai * HALF + m * 16) * ldc + col0;
#pragma unroll
                    for (int bj = 0; bj < 2; ++bj)
#pragma unroll
                        for (int n = 0; n < 2; ++n) __builtin_nontemporal_store(acc[ai][bj][m][n], (f32x4*)(rowp + bj * HALF + n * 16)); }
        } else {
#pragma unroll
            for (int ai = 0; ai < 2; ++ai)
#pragma unroll
                for (int m = 0; m < 4; ++m) { bf16_t* rowp = hb + (size_t)(row0 + ai * HALF + m * 16) * ldc + col0;
#pragma unroll
                    for (int bj = 0; bj < 2; ++bj)
#pragma unroll
                        for (int n = 0; n < 2; ++n) { const f32x4 v = acc[ai][bj][m][n] * sc; u32x2 w; w.x = cvt_pk_bf16(v[0], v[1]); w.y = cvt_pk_bf16(v[2], v[3]); *(u32x2*)(rowp + bj * HALF + n * 16) = w; } }
        }
    }
};
struct EpiTileBf16 {
    static constexpr bool PERM = false, AFTER_DRAIN = false;
    bf16_t* O; int mode;
    __device__ __forceinline__ void operator()(const f32x4 (&acc)[2][2][4][2], const Unit& u, int wr, int wc, int fr, int fq) const {
        const int tile = mode == 0 ? u.pm * 4 + u.pn : u.pn * 4 + u.pm;
        bf16_t* base = O + (size_t)tile * 65536; const int row0 = wr * 64 + fr, col0 = wc * 32 + 4 * fq;
#pragma unroll
        for (int ai = 0; ai < 2; ++ai)
#pragma unroll
            for (int m = 0; m < 4; ++m) { bf16_t* rowp = base + (size_t)(row0 + ai * HALF + m * 16) * 256 + col0;
#pragma unroll
                for (int bj = 0; bj < 2; ++bj)
#pragma unroll
                    for (int n = 0; n < 2; ++n) { const f32x4 v = acc[ai][bj][m][n]; u32x2 w; w.x = cvt_pk_bf16(v[0], v[1]); w.y = cvt_pk_bf16(v[2], v[3]); *(u32x2*)(rowp + bj * HALF + n * 16) = w; } }
    }
};
template <int MODE> struct EpiLora {
    static constexpr bool PERM = false, AFTER_DRAIN = false;
    float* O; const float* bias;
    __device__ __forceinline__ void operator()(const f32x4 (&acc)[2][2][4][2], const Unit& u, int wr, int wc, int fr, int fq) const {
        const int row0 = u.pm * BM + wr * 64 + fr, col0 = u.pn * BM + wc * 32 + 4 * fq;
#pragma unroll
        for (int bj = 0; bj < 2; ++bj)
#pragma unroll
            for (int n = 0; n < 2; ++n) { const f32x4 bv = *(const f32x4*)(bias + col0 + bj * HALF + n * 16);
#pragma unroll
                for (int ai = 0; ai < 2; ++ai)
#pragma unroll
                    for (int m = 0; m < 4; ++m) { f32x4 v = acc[ai][bj][m][n] + bv, o;
#pragma unroll
                        for (int e = 0; e < 4; ++e) { const float z = v[e];
                            const float sg = __builtin_amdgcn_rcpf(1.0f + __builtin_amdgcn_exp2f(-1.4426950408889634f * z));
                            if (MODE == 0) o[e] = __builtin_amdgcn_exp2f(-0.8750387749f * sg);
                            else o[e] = sg; }
                        __builtin_nontemporal_store(o, (f32x4*)(O + (size_t)(row0 + ai * HALF + m * 16) * 1536 + col0 + bj * HALF + n * 16)); } }
    }
};
struct EpiF32 {
    static constexpr bool PERM = false, AFTER_DRAIN = false;
    bf16_t* O; int ldc;
    __device__ __forceinline__ void operator()(const f32x4 (&acc)[2][2][4][2], const Unit& u, int wr, int wc, int fr, int fq) const {
        const int row0 = u.pm * BM + wr * 64 + fr, col0 = u.pn * BM + wc * 32 + 4 * fq;
#pragma unroll
        for (int ai = 0; ai < 2; ++ai)
#pragma unroll
            for (int m = 0; m < 4; ++m) { bf16_t* rowp = O + (size_t)(row0 + ai * HALF + m * 16) * ldc + col0;
#pragma unroll
                for (int bj = 0; bj < 2; ++bj)
#pragma unroll
                    for (int n = 0; n < 2; ++n) { const f32x4 v = acc[ai][bj][m][n]; u32x2 w; w.x = cvt_pk_bf16(v[0], v[1]); w.y = cvt_pk_bf16(v[2], v[3]); *(u32x2*)(rowp + bj * HALF + n * 16) = w; } }
    }
};
struct EpiSoftmax {
    static constexpr bool PERM = false, AFTER_DRAIN = true;
    bf16_t* P; float scale_l2;
    __device__ __forceinline__ void fused(f32x4 (&acc)[2][2][4][2], const Unit& u, int wr, int wc, int fr, int fq, PG8_LAS unsigned char* lds, int wid, int lane) const {
        PG8_LAS float* X = (PG8_LAS float*)lds;
        PG8_LAS float* Y = (PG8_LAS float*)(lds + 4096);
#pragma unroll
        for (int ai = 0; ai < 2; ++ai)
#pragma unroll
            for (int m = 0; m < 4; ++m) { float mx = -INFINITY;
#pragma unroll
                for (int bj = 0; bj < 2; ++bj)
#pragma unroll
                    for (int n = 0; n < 2; ++n) { const f32x4 x = acc[ai][bj][m][n]; mx = fmaxf(fmaxf(mx, fmaxf(x[0], x[1])), fmaxf(x[2], x[3])); }
                mx = fmaxf(mx, __shfl_xor(mx, 16)); mx = fmaxf(mx, __shfl_xor(mx, 32));
                if (fq == 0) X[(ai * HALF + wr * 64 + m * 16 + fr) * 4 + wc] = mx; }
        asm volatile("s_waitcnt lgkmcnt(0)" ::: "memory"); __builtin_amdgcn_s_barrier(); asm volatile("" ::: "memory");
#pragma unroll
        for (int ai = 0; ai < 2; ++ai)
#pragma unroll
            for (int m = 0; m < 4; ++m) { const int r = ai * HALF + wr * 64 + m * 16 + fr; const f32x4 q = *(const PG8_LAS f32x4*)(X + r * 4);
                const float mx = fmaxf(fmaxf(q[0], q[1]), fmaxf(q[2], q[3])) * scale_l2; float s = 0.f;
#pragma unroll
                for (int bj = 0; bj < 2; ++bj)
#pragma unroll
                    for (int n = 0; n < 2; ++n) { f32x4 x = acc[ai][bj][m][n];
#pragma unroll
                        for (int e = 0; e < 4; ++e) { x[e] = __builtin_amdgcn_exp2f(x[e] * scale_l2 - mx); s += x[e]; }
                        acc[ai][bj][m][n] = x; }
                s += __shfl_xor(s, 16); s += __shfl_xor(s, 32);
                if (fq == 0) Y[r * 4 + wc] = s; }
        asm volatile("s_waitcnt lgkmcnt(0)" ::: "memory"); __builtin_amdgcn_s_barrier(); asm volatile("" ::: "memory");
        bf16_t* base = P + (size_t)u.pm * 65536; const int col0 = wc * 32 + 4 * fq;
#pragma unroll
        for (int ai = 0; ai < 2; ++ai)
#pragma unroll
            for (int m = 0; m < 4; ++m) { const int r = ai * HALF + wr * 64 + m * 16 + fr; const f32x4 q = *(const PG8_LAS f32x4*)(Y + r * 4);
                const float inv = 1.0f / ((q[0] + q[1]) + (q[2] + q[3]));
#pragma unroll
                for (int bj = 0; bj < 2; ++bj)
#pragma unroll
                    for (int n = 0; n < 2; ++n) { const f32x4 v = acc[ai][bj][m][n] * inv; u32x2 w; w.x = cvt_pk_bf16(v[0], v[1]); w.y = cvt_pk_bf16(v[2], v[3]); *(u32x2*)(base + (size_t)r * 256 + col0 + bj * HALF + n * 16) = w; } }
        asm volatile("s_waitcnt lgkmcnt(0)" ::: "memory"); __builtin_amdgcn_s_barrier(); asm volatile("" ::: "memory");
    }
};
struct EpiMemOut {
    static constexpr bool PERM = false, AFTER_DRAIN = false;
    bf16_t* YC; const bf16_t* G;
    __device__ __forceinline__ void operator()(const f32x4 (&acc)[2][2][4][2], const Unit& u, int wr, int wc, int fr, int fq) const {
        const int h = u.pm >> 5, mt = u.pm & 31; const int row0 = mt * BM + wr * 64 + fr, col0 = 3072 + h * 256 + wc * 32 + 4 * fq;
#pragma unroll
        for (int ai = 0; ai < 2; ++ai)
#pragma unroll
            for (int m = 0; m < 4; ++m) { const size_t ro = (size_t)(row0 + ai * HALF + m * 16) * 4096 + col0;
#pragma unroll
                for (int bj = 0; bj < 2; ++bj)
#pragma unroll
                    for (int n = 0; n < 2; ++n) { const u32x2 gw = *(const u32x2*)(G + ro + bj * HALF + n * 16); f32x4 v = acc[ai][bj][m][n];
                        const float g0 = __uint_as_float(gw.x << 16), g1 = __uint_as_float(gw.x & 0xffff0000u), g2 = __uint_as_float(gw.y << 16), g3 = __uint_as_float(gw.y & 0xffff0000u);
                        v[0] *= g0 * sigmoidf_(g0); v[1] *= g1 * sigmoidf_(g1); v[2] *= g2 * sigmoidf_(g2); v[3] *= g3 * sigmoidf_(g3);
                        u32x2 w; w.x = cvt_pk_bf16(v[0], v[1]); w.y = cvt_pk_bf16(v[2], v[3]); *(u32x2*)(YC + ro + bj * HALF + n * 16) = w; } }
    }
};
struct QueueSched {
    unsigned* ctr; volatile PG8_LAS unsigned* ring; int count, nN, wave0;
    __device__ __forceinline__ bool leader() const { int l; asm volatile("v_mbcnt_lo_u32_b32 %0, -1, 0\n\tv_mbcnt_hi_u32_b32 %0, -1, %0" : "=v"(l)); return wave0 == 0 && l == 0; }
    __device__ __forceinline__ bool next(int i, Unit& u) const {
        if (i == 0) { if (leader()) { ring[0] = __hip_atomic_fetch_add(ctr, 1u, __ATOMIC_RELAXED, __HIP_MEMORY_SCOPE_AGENT); ring[1] = __hip_atomic_fetch_add(ctr, 1u, __ATOMIC_RELAXED, __HIP_MEMORY_SCOPE_AGENT); }
                      __syncthreads(); }
        else if (leader()) ring[(i + 1) & 3] = __hip_atomic_fetch_add(ctr, 1u, __ATOMIC_RELAXED, __HIP_MEMORY_SCOPE_AGENT);
        const int id = (int)ring[i & 3]; if (id >= count) return false;
        const int gsz = 8 * nN, gid = id / gsz, r = id % gsz; u.pm = gid * 8 + (r & 7); u.pn = r >> 3; return true; }
    __device__ __forceinline__ void a_ready(const Unit&) const {}
    __device__ __forceinline__ void done(const Unit&) const {}
};
struct ListSched {
    int first, stride, count, kind;
    int nN;
    __device__ __forceinline__ bool next(int i, Unit& u) const { const int id = first + i * stride; if (first < 0 || id >= count) return false;
        if (kind == 0) { u.pm = id / nN; u.pn = id % nN; } else { const int h = id >> 5, b = (id >> 4) & 1; u.pm = id; u.pn = 4 * b + h; } return true; }
    __device__ __forceinline__ void a_ready(const Unit&) const {}
    __device__ __forceinline__ void done(const Unit&) const {}
};
template <class Epi, class Sched, bool ALIGN_EPI = false, bool SP2 = false>
__device__ __forceinline__ void gemm_phase(PG8_LAS unsigned char* lds, const Gemm g, const Sched& S, const Epi& E, int tid_in) {
    int tid_ = tid_in; asm volatile("" : "+v"(tid_));
    const int tid = tid_, wid = __builtin_amdgcn_readfirstlane(tid >> 6), lane = tid & 63, wr = wid >> 2, wc = wid & 3, fr = lane & 15, fq = lane >> 4;
    const int K = g.K, nt = K / BK;
    unsigned voffA[2], voffB[2];
#pragma unroll
    for (int i = 0; i < 2; ++i) { int R, C; stage_rc(tid * 16 + i * 8192, R, C); const int Rb = Epi::PERM ? ((R & ~31) + perm32(R & 31)) : R;
        voffA[i] = (unsigned)(R * K + C) * 2u; voffB[i] = (unsigned)(Rb * K + C) * 2u; }
    const size_t kstep = (size_t)(BK * 2);
    const size_t hstep = (size_t)HALF * K * 2;
    const size_t tstep = 2 * hstep;
    const unsigned ldsw = (unsigned)wid * 1024u;
    const int aoff = lds_byte(wr * 64 + fr, fq * 8), boff = lds_byte(wc * 32 + fr, fq * 8);
#define PG8_SA(b, h) (((b) * 2 + (h)) * HTB)
#define PG8_SB(b, h) ((4 + (b) * 2 + (h)) * HTB)
#define PG8_STAGE(bufoff, gbase, voff) do { _Pragma("unroll") for (int _i = 0; _i < 2; ++_i) \
        __builtin_amdgcn_global_load_lds((const unsigned*)((const char*)(gbase) + (voff)[_i]), (PG8_LAS unsigned*)(lds + (bufoff) + ldsw + _i * 8192), 16, 0, 0); } while (0)
#define PG8_LDA(dst, b, h) do { _Pragma("unroll") for (int m = 0; m < 4; ++m) _Pragma("unroll") for (int k = 0; k < 2; ++k) dst[m][k] = *(const PG8_LAS bf16x8*)(lds + PG8_SA(b, h) + aoff + m * 2048 + k * 1024); } while (0)
#define PG8_LDB(dst, b, h) do { _Pragma("unroll") for (int n = 0; n < 2; ++n) _Pragma("unroll") for (int k = 0; k < 2; ++k) dst[n][k] = *(const PG8_LAS bf16x8*)(lds + PG8_SB(b, h) + boff + n * 2048 + k * 1024); } while (0)
#define PG8_MMA(ai, bj, At, Bt) do { __builtin_amdgcn_s_setprio(1); _Pragma("unroll") for (int m = 0; m < 4; ++m) _Pragma("unroll") for (int n = 0; n < 2; ++n) _Pragma("unroll") for (int k = 0; k < 2; ++k) \
        acc[ai][bj][m][n] = __builtin_amdgcn_mfma_f32_16x16x32_bf16(Bt[n][k], At[m][k], acc[ai][bj][m][n], 0, 0, 0); __builtin_amdgcn_s_setprio(0); } while (0)
#define PG8_WAIT_V(n) asm volatile("s_waitcnt vmcnt(" #n ")" ::: "memory")
#define PG8_WAIT_L(n) asm volatile("s_waitcnt lgkmcnt(" #n ")" ::: "memory")
#define PG8_BAR __builtin_amdgcn_s_barrier()
#define PG8_SCHED __builtin_amdgcn_sched_barrier(0)
    Unit cur, nxt; int ui = 0;
    if (!S.next(0, cur)) return;
    f32x4 acc[2][2][4][2];
#pragma unroll
    for (int a = 0; a < 2; ++a)
#pragma unroll
        for (int b = 0; b < 2; ++b)
#pragma unroll
            for (int m = 0; m < 4; ++m)
#pragma unroll
                for (int n = 0; n < 2; ++n) acc[a][b][m][n] = (f32x4){0.f, 0.f, 0.f, 0.f};
    bf16x8 At[4][2], B0[2][2], B1[2][2];
    const char* cA = (const char*)g.A + (size_t)cur.pm * tstep; const char* cB = (const char*)g.Bt + (size_t)cur.pn * tstep;
    S.a_ready(cur);
    if constexpr (SP2) {
        PG8_STAGE(PG8_SB(0, 0), cB, voffB); PG8_STAGE(PG8_SB(0, 1), cB + hstep, voffB); PG8_STAGE(PG8_SA(0, 0), cA, voffA); PG8_STAGE(PG8_SA(0, 1), cA + hstep, voffA);
        if (wr == 1) PG8_BAR;
        PG8_WAIT_V(2); PG8_BAR;
        PG8_STAGE(PG8_SB(1, 0), cB + kstep, voffB); PG8_STAGE(PG8_SA(1, 0), cA + kstep, voffA); PG8_STAGE(PG8_SB(1, 1), cB + hstep + kstep, voffB);
        PG8_WAIT_V(6); PG8_BAR;
    } else {
        PG8_STAGE(PG8_SB(0, 0), cB, voffB); PG8_STAGE(PG8_SA(0, 0), cA, voffA); PG8_STAGE(PG8_SB(0, 1), cB + hstep, voffB); PG8_STAGE(PG8_SA(0, 1), cA + hstep, voffA);
        if (wr == 1) PG8_BAR;
        PG8_WAIT_V(4); PG8_BAR;
        PG8_STAGE(PG8_SB(1, 0), cB + kstep, voffB); PG8_STAGE(PG8_SA(1, 0), cA + kstep, voffA); PG8_STAGE(PG8_SB(1, 1), cB + hstep + kstep, voffB);
        PG8_WAIT_V(6); PG8_BAR;
    }
    for (;;) {
        const bool has_next = S.next(ui + 1, nxt);
        const char* nA = has_next ? (const char*)g.A + (size_t)nxt.pm * tstep : cA; const char* nB = has_next ? (const char*)g.Bt + (size_t)nxt.pn * tstep : cB;
        for (int t = 0; t < nt; t += 2) {
            const bool last = (t == nt - 2);
            const char* a1 = cA + (size_t)(t + 1) * kstep;
            const char* a2 = last ? nA : cA + (size_t)(t + 2) * kstep; const char* b2 = last ? nB : cB + (size_t)(t + 2) * kstep;
            const char* a3 = a2 + kstep; const char* b3 = b2 + kstep;
            if (last && has_next) S.a_ready(nxt);
            if constexpr (SP2) {
            PG8_LDB(B0, 0, 0); PG8_LDB(B1, 0, 1); PG8_SCHED; PG8_LDA(At, 0, 0); PG8_STAGE(PG8_SA(1, 1), a1 + hstep, voffA);
            PG8_WAIT_V(8); PG8_WAIT_L(0); PG8_BAR; PG8_MMA(0, 0, At, B0); PG8_MMA(0, 1, At, B1); PG8_BAR; PG8_SCHED;
            PG8_LDA(At, 0, 1); PG8_STAGE(PG8_SB(0, 0), b2, voffB); PG8_STAGE(PG8_SB(0, 1), b2 + hstep, voffB); PG8_STAGE(PG8_SA(0, 0), a2, voffA);
            PG8_WAIT_V(8); PG8_WAIT_L(0); PG8_BAR; PG8_MMA(1, 0, At, B0); PG8_MMA(1, 1, At, B1); PG8_BAR; PG8_SCHED;
            PG8_LDB(B0, 1, 0); PG8_LDB(B1, 1, 1); PG8_SCHED; PG8_LDA(At, 1, 0); PG8_STAGE(PG8_SA(0, 1), a2 + hstep, voffA);
            PG8_WAIT_V(8); PG8_WAIT_L(0); PG8_BAR; PG8_MMA(0, 0, At, B0); PG8_MMA(0, 1, At, B1); PG8_BAR; PG8_SCHED;
            PG8_LDA(At, 1, 1); PG8_STAGE(PG8_SB(1, 0), b3, voffB); PG8_STAGE(PG8_SB(1, 1), b3 + hstep, voffB); PG8_STAGE(PG8_SA(1, 0), a3, voffA);
            PG8_WAIT_V(8); PG8_WAIT_L(0); PG8_BAR; PG8_MMA(1, 0, At, B0); PG8_MMA(1, 1, At, B1); PG8_BAR; PG8_SCHED;
            } else {
            PG8_LDB(B0, 0, 0); PG8_SCHED; PG8_LDA(At, 0, 0); PG8_STAGE(PG8_SA(1, 1), a1 + hstep, voffA);
            PG8_WAIT_L(8); PG8_BAR; PG8_WAIT_L(0); PG8_MMA(0, 0, At, B0); PG8_BAR; PG8_SCHED;
            PG8_LDB(B1, 0, 1); PG8_STAGE(PG8_SB(0, 0), b2, voffB);
            PG8_BAR; PG8_WAIT_L(0); PG8_MMA(0, 1, At, B1); PG8_BAR;
            PG8_LDA(At, 0, 1); PG8_STAGE(PG8_SA(0, 0), a2, voffA);
            PG8_BAR; PG8_WAIT_L(0); PG8_MMA(1, 0, At, B0); PG8_BAR; PG8_SCHED;
            PG8_STAGE(PG8_SB(0, 1), b2 + hstep, voffB);
            PG8_WAIT_V(6); PG8_BAR; PG8_MMA(1, 1, At, B1); PG8_BAR;
            PG8_LDB(B0, 1, 0); PG8_SCHED; PG8_LDA(At, 1, 0); PG8_STAGE(PG8_SA(0, 1), a2 + hstep, voffA);
            PG8_WAIT_L(8); PG8_BAR; PG8_WAIT_L(0); PG8_MMA(0, 0, At, B0); PG8_BAR; PG8_SCHED;
            PG8_LDB(B1, 1, 1); PG8_STAGE(PG8_SB(1, 0), b3, voffB);
            PG8_BAR; PG8_WAIT_L(0); PG8_MMA(0, 1, At, B1); PG8_BAR;
            PG8_LDA(At, 1, 1); PG8_STAGE(PG8_SA(1, 0), a3, voffA);
            PG8_BAR; PG8_WAIT_L(0); PG8_MMA(1, 0, At, B0); PG8_BAR; PG8_SCHED;
            PG8_STAGE(PG8_SB(1, 1), b3 + hstep, voffB);
            PG8_WAIT_V(6); PG8_BAR; PG8_MMA(1, 1, At, B1); PG8_BAR;
            }
        }
        if constexpr (ALIGN_EPI) { if (wr == 0) PG8_BAR; }
        if constexpr (!Epi::AFTER_DRAIN) { E(acc, cur, wr, wc, fr, fq); S.done(cur); }
        if (!has_next) break;
#pragma unroll
        for (int a = 0; a < 2; ++a)
#pragma unroll
            for (int b = 0; b < 2; ++b)
#pragma unroll
                for (int m = 0; m < 4; ++m)
#pragma unroll
                    for (int n = 0; n < 2; ++n) acc[a][b][m][n] = (f32x4){0.f, 0.f, 0.f, 0.f};
        cur = nxt; cA = nA; cB = nB; ++ui;
        if constexpr (ALIGN_EPI) { if (wr == 1) PG8_BAR; }
    }
    PG8_WAIT_V(0);
    if constexpr (!ALIGN_EPI) { if (wr == 0) PG8_BAR; }
    PG8_BAR;
    if constexpr (Epi::AFTER_DRAIN) { E.fused(acc, cur, wr, wc, fr, fq, lds, wid, lane); S.done(cur); }
#undef PG8_SA
#undef PG8_SB
#undef PG8_STAGE
#undef PG8_LDA
#undef PG8_LDB
#undef PG8_MMA
#undef PG8_WAIT_V
#undef PG8_WAIT_L
#undef PG8_BAR
#undef PG8_SCHED
}
}

#ifndef PG8_SP2
#define PG8_SP2 true
#endif
#ifndef PG8_ALIGN
#define PG8_ALIGN true
#endif
#include <hip/hip_bf16.h>
#include <cmath>
namespace attn_body {
using bf16=__hip_bfloat16;
using bf16x8=__attribute__((ext_vector_type(8)))short;
using s16x4=__attribute__((ext_vector_type(4)))short;
using f32x16=__attribute__((ext_vector_type(16)))float;
using u32x4=__attribute__((ext_vector_type(4)))unsigned;
using f32x4v=__attribute__((ext_vector_type(4)))float;
constexpr int BATCH=2,NHEAD=24,SEQ=4096,D=64,DM=NHEAD*D,OP=4096;
constexpr int NW=8,QBLK=32,QB=QBLK*NW,KVBLK=64,NQB=SEQ/QB;
constexpr int ATTN_PITCH=DM, ATTN_UNIT_ROWS=QB;
__device__ __forceinline__ int crow(int r,int hi){return (r&3)+8*(r>>2)+4*hi;}
#define SBAR() __builtin_amdgcn_sched_barrier(0)
__device__ __forceinline__ void cmask(f32x16&p0,f32x16&p1,int jb,int qrel,int hi){
  const float NEG=-INFINITY; int kb=64*jb+4*hi;
  #pragma unroll
  for(int r=0;r<16;++r){int kv=kb+(r&3)+8*(r>>2); if(kv>qrel)p0[r]=NEG; if(kv+32>qrel)p1[r]=NEG;}
}

constexpr int NSLOT=3, SLOTB=8192;
constexpr int LDS_K=0, LDS_V=NSLOT*SLOTB, LDS_WS=2*NSLOT*SLOTB, LDS_OST=LDS_WS+NW*64*4, LDS_BYTES=LDS_OST+NW*4096;
constexpr float C2=0.125f*1.4426950408889634f;
__device__ __forceinline__ void glds16(const void*gsrc,unsigned lds_dst){unsigned keep;
  asm volatile("s_mov_b32 %0, m0\n\ts_mov_b32 m0, %2\n\ts_nop 0\n\tglobal_load_lds_dwordx4 %1, off\n\ts_mov_b32 m0, %0":"=&s"(keep):"v"(gsrc),"s"(lds_dst):"memory");}
__device__ __forceinline__ float max3f(float a,float b,float c){float r;asm("v_max3_f32 %0, %1, %2, %3":"=v"(r):"v"(a),"v"(b),"v"(c));return r;}
__device__ __forceinline__ float max2f(float a,float b){float r;asm("v_max_f32_e32 %0, %1, %2":"=v"(r):"v"(a),"v"(b));return r;}
__device__ __forceinline__ float fadd_s(float a,float b){float r;asm("v_add_f32_e32 %0, %1, %2":"=v"(r):"v"(a),"v"(b));return r;}
__device__ __forceinline__ float fsub_s(float a,float b){float r;asm("v_sub_f32_e32 %0, %1, %2":"=v"(r):"v"(a),"v"(b));return r;}
typedef float f32x2_t __attribute__((ext_vector_type(2))); typedef __bf16 bf16x2_t __attribute__((ext_vector_type(2)));
__device__ __forceinline__ unsigned cvtpk_s(float lo,float hi){f32x2_t v={lo,hi};bf16x2_t b=__builtin_convertvector(v,bf16x2_t);return __builtin_bit_cast(unsigned,b);}
#define WAIT_BAR(N) asm volatile("s_waitcnt vmcnt(" #N ") lgkmcnt(0)\n\ts_barrier":::"memory")

__device__ __forceinline__ void qkt(f32x16&p0,f32x16&p1,const char*Kslot,const bf16x8*qr,int r32,int hi){
  const char*kb=Kslot+hi*1024+r32*16;
  #pragma unroll
  for(int d0=0;d0<4;++d0){
    const bf16x8 b0=*reinterpret_cast<const bf16x8*>(kb+d0*2048);
    const bf16x8 b1=*reinterpret_cast<const bf16x8*>(kb+d0*2048+512);
    {p0=__builtin_amdgcn_mfma_f32_32x32x16_bf16(b0,qr[d0],p0,0,0,0);p1=__builtin_amdgcn_mfma_f32_32x32x16_bf16(b1,qr[d0],p1,0,0,0);}}
}
typedef __attribute__((address_space(3))) const char* lds_cptr;
typedef short v4i16_t __attribute__((ext_vector_type(4)));
__device__ __forceinline__ void kload8(bf16x8*kf,lds_cptr kp){
  kf[0]=*(const __attribute__((address_space(3))) bf16x8*)(kp);      kf[1]=*(const __attribute__((address_space(3))) bf16x8*)(kp+512);
  kf[2]=*(const __attribute__((address_space(3))) bf16x8*)(kp+2048); kf[3]=*(const __attribute__((address_space(3))) bf16x8*)(kp+2560);
  kf[4]=*(const __attribute__((address_space(3))) bf16x8*)(kp+4096); kf[5]=*(const __attribute__((address_space(3))) bf16x8*)(kp+4608);
  kf[6]=*(const __attribute__((address_space(3))) bf16x8*)(kp+6144); kf[7]=*(const __attribute__((address_space(3))) bf16x8*)(kp+6656);
}
__device__ __forceinline__ void kload2(bf16x8*kf,lds_cptr kp,int j){ kf[2*j]=*(const __attribute__((address_space(3))) bf16x8*)(kp+j*2048); kf[2*j+1]=*(const __attribute__((address_space(3))) bf16x8*)(kp+j*2048+512); }
__device__ __forceinline__ s16x4 vtr(lds_cptr p){ return __builtin_bit_cast(s16x4,__builtin_amdgcn_ds_read_tr16_b64_v4i16((__attribute__((address_space(3))) v4i16_t*)p)); }
__device__ __forceinline__ float rowmax(const f32x16&p0,const f32x16&p1){
  float a=max3f(p0[0],p0[1],p1[0]),b=max3f(p0[2],p0[3],p1[1]);a=max3f(a,p1[2],p1[3]);
  #pragma unroll
  for(int r=4;r<16;r+=4){a=max3f(a,p0[r],p0[r+1]);b=max3f(b,p0[r+2],p0[r+3]);a=max3f(a,p1[r],p1[r+1]);b=max3f(b,p1[r+2],p1[r+3]);}
  const float m=max2f(a,b);
  auto rr=__builtin_amdgcn_permlane32_swap(__float_as_uint(m),__float_as_uint(m),false,false);
  return max2f(__uint_as_float(rr[0]),__uint_as_float(rr[1]));
}
__device__ __forceinline__ void pv(f32x16*o,int vb,bf16x8 pa0,bf16x8 pa1,bf16x8 pa2,bf16x8 pa3){
  #pragma unroll
  for(int d0=0;d0<2;++d0){s16x4 lo[4],hi[4];
    #pragma unroll
    for(int ks=0;ks<4;++ks){
      asm volatile("ds_read_b64_tr_b16 %0,%1 offset:%c2":"=&v"(lo[ks]):"v"(vb),"i"(d0*4096+ks*1024):"memory");
      asm volatile("ds_read_b64_tr_b16 %0,%1 offset:%c2":"=&v"(hi[ks]):"v"(vb),"i"(d0*4096+ks*1024+512):"memory");}
    asm volatile("s_waitcnt lgkmcnt(0)":::"memory");SBAR();
    #define PK(k) (bf16x8){lo[k][0],lo[k][1],lo[k][2],lo[k][3],hi[k][0],hi[k][1],hi[k][2],hi[k][3]}
    o[d0]=__builtin_amdgcn_mfma_f32_32x32x16_bf16(pa0,PK(0),o[d0],0,0,0);
    o[d0]=__builtin_amdgcn_mfma_f32_32x32x16_bf16(pa1,PK(1),o[d0],0,0,0);
    o[d0]=__builtin_amdgcn_mfma_f32_32x32x16_bf16(pa2,PK(2),o[d0],0,0,0);
    o[d0]=__builtin_amdgcn_mfma_f32_32x32x16_bf16(pa3,PK(3),o[d0],0,0,0);
    #undef PK
  }
}

#ifndef ATTN_STORE16
#define ATTN_STORE16(p,v) (*(u32x4*)(p)=(v))
#endif
template<int THRL> __device__ __forceinline__ void attn_unit(int b,int h,int qb,const bf16*Q,const bf16*__restrict__ K,const bf16*__restrict__ V,bf16*O,const bf16*Gt,const float*CUM,char*shm,int tid_in){
  int tid_=tid_in; asm volatile("":"+v"(tid_)); const int tid=tid_,lane=tid&63,r32=lane&31,hi=lane>>5; const int wid=__builtin_amdgcn_readfirstlane(tid>>6);
  const long rowbase=(long)b*SEQ; const int q0=qb*QB;
  const bf16*Qw=Q+(rowbase+q0+wid*QBLK)*DM+h*D;
  const bf16*Kh=K+rowbase*DM+h*D,*Vh=V+rowbase*DM+h*D;
  const lds_cptr shm3b=(lds_cptr)shm; const unsigned lds0=(unsigned)(uintptr_t)shm;
  float*wsf=(float*)(shm+LDS_WS)+wid*64;
  const bf16*ksrc=Kh+(long)lane*DM+wid*8;
  const bf16*vsrc=Vh+(long)(16*(wid&3)+(lane>>2))*DM+(wid>>2)*32+(lane&3)*8;
  const unsigned kdst=lds0+LDS_K+wid*1024, vdst=lds0+LDS_V+wid*1024;
  #define DMA_K(t,slot) glds16(ksrc+(long)(t)*KVBLK*DM,(unsigned)__builtin_amdgcn_readfirstlane(kdst+(slot)))
  #define DMA_V(t,slot) glds16(vsrc+(long)(t)*KVBLK*DM,(unsigned)__builtin_amdgcn_readfirstlane(vdst+(slot)))
  const int vb0=(int)(lds0+LDS_V)+((lane>>4)&1)*32+(lane&3)*8+(4*hi+((lane&15)>>2))*64;
  const char*Kbase=shm+LDS_K; bf16x8 kf[8];
  const lds_cptr shm3=(lds_cptr)shm; const lds_cptr kp0=shm3+LDS_K+hi*1024+r32*16; const lds_cptr vp0=shm3+LDS_V+((lane>>4)&1)*32+(lane&3)*8+(4*hi+((lane&15)>>2))*64;
  const int NT=(q0+QB)/KVBLK;
  DMA_K(0,0);DMA_V(0,0);DMA_K(1,SLOTB);
  const float*CUMh=CUM+(long)(b*NHEAD+h)*SEQ; __attribute__((address_space(3))) float*beta3=(__attribute__((address_space(3))) float*)(shm3b+LDS_BYTES);
  { const float c0=CUMh[q0]; float cv_[SEQ/(NW*64)];
    _Pragma("unroll") for(int i_=0;i_<SEQ/(NW*64);++i_){ const int s_=tid+i_*NW*64; cv_[i_]=(s_<q0+QB)?CUMh[s_]:0.f; }
    _Pragma("unroll") for(int i_=0;i_<SEQ/(NW*64);++i_){ const int s_=tid+i_*NW*64; if(s_<q0+QB) beta3[s_]=(c0-cv_[i_])*1.4426950408889634f; } }
  bf16x8 qr[4];
  #pragma unroll
  for(int d0=0;d0<4;++d0)qr[d0]=*reinterpret_cast<const bf16x8*>(&Qw[(long)r32*DM+d0*16+hi*8]);
  float mhat=0.f,l_reg=0.f;f32x16 o[2];o[0]=f32x16{};o[1]=f32x16{};
  const int qrel=wid*QBLK+r32;
  #define CMASK(P0,P1,t) do{int jb_=(t)-(NT-4); if(jb_>=0)cmask(P0,P1,jb_,qrel,hi);}while(0)
  bool resc=false;
  #define START(P0,P1) do{ resc=false; \
    _Pragma("unroll") for(int r=0;r<16;++r)P0[r]=__builtin_amdgcn_exp2f(P0[r]); }while(0)
  #define BLOAD(P0,P1,tn) do{ const __attribute__((address_space(3))) f32x4v* bp_=(const __attribute__((address_space(3))) f32x4v*)(beta3+(tn)*64+4*hi); \
    _Pragma("unroll") for(int g_=0;g_<4;++g_){ const f32x4v a_=bp_[2*g_], b_=bp_[8+2*g_]; \
      P0[4*g_]=a_[0];P0[4*g_+1]=a_[1];P0[4*g_+2]=a_[2];P0[4*g_+3]=a_[3]; P1[4*g_]=b_[0];P1[4*g_+1]=b_[1];P1[4*g_+2]=b_[2];P1[4*g_+3]=b_[3]; } }while(0)
  #define BSUB(P0,P1) do{ _Pragma("unroll") for(int r=0;r<16;++r){P0[r]=fsub_s(P0[r],mhat);P1[r]=fsub_s(P1[r],mhat);} }while(0)
  #define RESC() do{ if(resc){ asm volatile("s_waitcnt lgkmcnt(0)":::"memory"); \
      _Pragma("unroll") for(int d_=0;d_<2;++d_) _Pragma("unroll") for(int r=0;r<16;++r)o[d_][r]*=wsf[crow(r,hi)]; } }while(0)
  f32x16 pA0,pA1,pB0,pB1;
  int sl_prev=0,sl_cur=0,sl_next=SLOTB;
  #define ROT() do{sl_prev=sl_cur;sl_cur=sl_next;sl_next=(sl_next==(NSLOT-1)*SLOTB)?0:sl_next+SLOTB;}while(0)
  DMA_K(2,2*SLOTB);
  WAIT_BAR(3);
  mhat=beta3[q0+qrel];
  BLOAD(pA0,pA1,0); BSUB(pA0,pA1);
  qkt(pA0,pA1,Kbase,qr,r32,hi);asm volatile("s_nop 15\n\ts_nop 7":"+v"(pA0),"+v"(pA1));CMASK(pA0,pA1,0);
  START(pA0,pA1);
  BLOAD(pB0,pB1,1); BSUB(pB0,pB1);
  _Pragma("unroll") for(int r=0;r<16;++r)pA1[r]=__builtin_amdgcn_exp2f(pA1[r]);
  WAIT_BAR(0);
  DMA_K(3,0);DMA_V(1,SLOTB);
  ROT();
  kload8(kf,kp0+sl_cur);
  WAIT_BAR(2);
  s16x4 vlo[8],vhi[8]; u32x4 pw0,pw1,pw2,pw3;
  #define PKW(P,B) cvtpk_s(P[B],P[B+1])
  #define PAF(k) __builtin_bit_cast(bf16x8,pw##k)
  #define VFR(i) (bf16x8){vlo[i][0],vlo[i][1],vlo[i][2],vlo[i][3],vhi[i][0],vhi[i][1],vhi[i][2],vhi[i][3]}
  #define PIN(x) asm volatile("":"+v"(x))
  #define MX3(a,b,c) __builtin_fmaxf(__builtin_fmaxf((a),(b)),(c))
  #define GAPA(MF,A0,A1,A2,A3,W0,W1,PW) do{ MF; sacc+=A0; sacc+=A1; sacc+=A2; sacc+=A3; PIN(sacc); W0; W1; PIN(PW); SBAR(); }while(0)
  #define EX(v) __builtin_amdgcn_exp2f(v)
  #define GAPB(MF,X,B) do{ MF; X[B]=EX(X[B]); X[B+1]=EX(X[B+1]); X[B+2]=EX(X[B+2]); X[B+3]=EX(X[B+3]); PIN(X); SBAR(); }while(0)
  #define VRD(i) do{ vlo[i]=vtr(vp_+(((i)>>2)*4096+((i)&3)*1024)); vhi[i]=vtr(vp_+(((i)>>2)*4096+((i)&3)*1024+512)); }while(0)
  #define KRD(G,j) do{ if(G){ kload2(kf,kp0+sl_next,j); SBAR(); } }while(0)
  #define STEP(C0,C1,P0,P1,t,GK,GV,GL) do{ SBAR(); \
    const lds_cptr vp_=vp0+sl_prev; \
    VRD(0); SBAR(); float sacc=(P0[0]+P0[1]); \
    GAPA(C0=__builtin_amdgcn_mfma_f32_32x32x16_bf16(kf[0],qr[0],C0,0,0,0), P0[2],P0[3],P0[4],P0[5],     pw0[0]=PKW(P0,0), pw0[1]=PKW(P0,2), pw0); \
    VRD(4); SBAR(); GAPA(C1=__builtin_amdgcn_mfma_f32_32x32x16_bf16(kf[1],qr[0],C1,0,0,0), P0[6],P0[7],P0[8],P0[9],     pw0[2]=PKW(P0,4), pw0[3]=PKW(P0,6), pw0); \
    VRD(1); SBAR(); GAPA(C0=__builtin_amdgcn_mfma_f32_32x32x16_bf16(kf[2],qr[1],C0,0,0,0),   P0[10],P0[11],P0[12],P0[13], pw1[0]=PKW(P0,8), pw1[1]=PKW(P0,10), pw1); \
    VRD(5); SBAR(); GAPA(C1=__builtin_amdgcn_mfma_f32_32x32x16_bf16(kf[3],qr[1],C1,0,0,0),   P0[14],P0[15],P1[0],P1[1],   pw1[2]=PKW(P0,12),pw1[3]=PKW(P0,14), pw1); \
    VRD(2); SBAR(); GAPA(C0=__builtin_amdgcn_mfma_f32_32x32x16_bf16(kf[4],qr[2],C0,0,0,0),   P1[2],P1[3],P1[4],P1[5],     pw2[0]=PKW(P1,0), pw2[1]=PKW(P1,2), pw2); \
    VRD(6); SBAR(); GAPA(C1=__builtin_amdgcn_mfma_f32_32x32x16_bf16(kf[5],qr[2],C1,0,0,0),   P1[6],P1[7],P1[8],P1[9],     pw2[2]=PKW(P1,4), pw2[3]=PKW(P1,6), pw2); \
    VRD(3); SBAR(); GAPA(C0=__builtin_amdgcn_mfma_f32_32x32x16_bf16(kf[6],qr[3],C0,0,0,0),   P1[10],P1[11],P1[12],P1[13], pw3[0]=PKW(P1,8), pw3[1]=PKW(P1,10), pw3); \
    VRD(7); SBAR(); GAPA(C1=__builtin_amdgcn_mfma_f32_32x32x16_bf16(kf[7],qr[3],C1,0,0,0),   P1[14],P1[15],0.f,0.f,       pw3[2]=PKW(P1,12),pw3[3]=PKW(P1,14), pw3); \
    l_reg+=sacc; \
    if(GK){DMA_K((t)+3,sl_cur);} if(GV){DMA_V((t)+1,sl_next);} \
    CMASK(C0,C1,t); \
    { float a=MX3(C0[0],C0[1],C1[0]),b=MX3(C0[2],C0[3],C1[1]); a=MX3(a,C1[2],C1[3]); \
      _Pragma("unroll") for(int r=4;r<16;r+=4){a=MX3(a,C0[r],C0[r+1]);b=MX3(b,C0[r+2],C0[r+3]);a=MX3(a,C1[r],C1[r+1]);b=MX3(b,C1[r+2],C1[r+3]);} \
      float rm=__builtin_fmaxf(a,b); { auto rr=__builtin_amdgcn_permlane32_swap(__float_as_uint(rm),__float_as_uint(rm),false,false); rm=__builtin_fmaxf(__uint_as_float(rr[0]),__uint_as_float(rr[1])); } \
      resc=false; \
      if(__builtin_expect(__any(rm>(float)THRL),0)){ const float dl=__builtin_fmaxf(rm,0.f); mhat+=dl; \
        _Pragma("unroll") for(int r=0;r<16;++r){C0[r]-=dl;C1[r]-=dl;} \
        const float f=__builtin_amdgcn_exp2f(-dl); l_reg*=f; if(hi==0)wsf[r32]=f; resc=true; } } \
    SBAR(); \
    GAPB(o[0]=__builtin_amdgcn_mfma_f32_32x32x16_bf16(PAF(0),VFR(0),o[0],0,0,0), C0,0); \
    GAPB(o[1]=__builtin_amdgcn_mfma_f32_32x32x16_bf16(PAF(0),VFR(4),o[1],0,0,0), C0,4); \
    KRD(GL,0); GAPB(o[0]=__builtin_amdgcn_mfma_f32_32x32x16_bf16(PAF(1),VFR(1),o[0],0,0,0), C0,8); \
    KRD(GL,1); GAPB(o[1]=__builtin_amdgcn_mfma_f32_32x32x16_bf16(PAF(1),VFR(5),o[1],0,0,0), C0,12); \
    KRD(GL,2); GAPB(o[0]=__builtin_amdgcn_mfma_f32_32x32x16_bf16(PAF(2),VFR(2),o[0],0,0,0), C1,0); \
    KRD(GL,3); GAPB(o[1]=__builtin_amdgcn_mfma_f32_32x32x16_bf16(PAF(2),VFR(6),o[1],0,0,0), C1,4); \
    BLOAD(P0,P1,(t)+1); SBAR(); \
    GAPB(o[0]=__builtin_amdgcn_mfma_f32_32x32x16_bf16(PAF(3),VFR(3),o[0],0,0,0), C1,8); \
    GAPB(o[1]=__builtin_amdgcn_mfma_f32_32x32x16_bf16(PAF(3),VFR(7),o[1],0,0,0), C1,12); \
    BSUB(P0,P1); SBAR(); \
    }while(0)
  int t=1;
  #undef CMASK
  #define CMASK(P0,P1,t) do{}while(0)
  for(;t+5<NT;t+=2){
    STEP(pB0,pB1,pA0,pA1,t,true,true,true);     WAIT_BAR(2); RESC(); ROT();
    STEP(pA0,pA1,pB0,pB1,t+1,true,true,true);   WAIT_BAR(2); RESC(); ROT();
  }
  #undef CMASK
  #define CMASK(P0,P1,t) do{int jb_=(t)-(NT-4); if(jb_>=0)cmask(P0,P1,jb_,qrel,hi);}while(0)
  #define ENDW(tt) do{ if((tt)+3<NT){WAIT_BAR(2);} else if((tt)+2<NT){WAIT_BAR(1);} else {WAIT_BAR(0);} }while(0)
  for(;t+1<NT;t+=2){
    STEP(pB0,pB1,pA0,pA1,t,(t+3<NT),(t+1<NT),(t+1<NT));       ENDW(t);   RESC(); ROT();
    STEP(pA0,pA1,pB0,pB1,t+1,(t+4<NT),(t+2<NT),(t+2<NT));     ENDW(t+1); RESC(); ROT();
  }
  STEP(pB0,pB1,pA0,pA1,NT-1,false,false,false); RESC();
  { float sacc=pB0[0]+pB0[1]; _Pragma("unroll") for(int r=2;r<16;++r)sacc+=pB0[r]; _Pragma("unroll") for(int r=0;r<16;++r)sacc+=pB1[r]; l_reg+=sacc;
    pw0=(u32x4){PKW(pB0,0),PKW(pB0,2),PKW(pB0,4),PKW(pB0,6)};pw1=(u32x4){PKW(pB0,8),PKW(pB0,10),PKW(pB0,12),PKW(pB0,14)};pw2=(u32x4){PKW(pB1,0),PKW(pB1,2),PKW(pB1,4),PKW(pB1,6)};pw3=(u32x4){PKW(pB1,8),PKW(pB1,10),PKW(pB1,12),PKW(pB1,14)};
    SBAR(); pv(o,vb0+sl_cur,PAF(0),PAF(1),PAF(2),PAF(3)); }
  #undef PKW
  #undef PAF
  #undef VFR
  #undef PIN
  #undef MX3
  #undef GAPA
  #undef GAPB
  #undef EX
  #undef VRD
  #undef KRD
  #undef STEP
  #undef ENDW
  {auto rr=__builtin_amdgcn_permlane32_swap(__float_as_uint(l_reg),__float_as_uint(l_reg),false,false);l_reg=__uint_as_float(rr[0])+__uint_as_float(rr[1]);}
  if(hi==0)wsf[32+r32]=l_reg;asm volatile("s_waitcnt lgkmcnt(0)":::"memory");
  float rli[16];
  #pragma unroll
  for(int r=0;r<16;++r)rli[r]=__builtin_amdgcn_rcpf(wsf[32+crow(r,hi)]);
  bf16*Ow=O+(rowbase+q0+wid*QBLK)*OP+h*D; const bf16*Gw=Gt+(rowbase+q0+wid*QBLK)*OP+h*D;
  u32x4 gq_[4];
  _Pragma("unroll") for(int i=0;i<4;++i) gq_[i]=*(const u32x4*)(Gw+(long)(i*8+(lane>>3))*OP+(lane&7)*8);
  { bf16*stg=(bf16*)(shm+LDS_OST)+wid*2048;
    #pragma unroll
    for(int r=0;r<16;++r){const int orow=crow(r,hi);
      #pragma unroll
      for(int d0=0;d0<2;++d0)stg[orow*64+d0*32+r32]=__float2bfloat16(o[d0][r]*rli[r]);}
    asm volatile("s_waitcnt lgkmcnt(0)":::"memory");
    #pragma unroll
    for(int i=0;i<4;++i){const int row=i*8+(lane>>3),ch=lane&7; u32x4 v=*(const u32x4*)(stg+row*64+ch*8); const u32x4 g=gq_[i];
      _Pragma("unroll") for(int e=0;e<4;++e){ const float g0=__uint_as_float(g[e]<<16),g1=__uint_as_float(g[e]&0xffff0000u); const float x0=__uint_as_float(v[e]<<16),x1=__uint_as_float(v[e]&0xffff0000u);
        v[e]=cvtpk_s(x0*g0*__builtin_amdgcn_rcpf(1.f+__expf(-g0)), x1*g1*__builtin_amdgcn_rcpf(1.f+__expf(-g1))); }
      ATTN_STORE16(Ow+(long)row*OP+ch*8,v);} }
  asm volatile("s_waitcnt lgkmcnt(0)\n\ts_barrier":::"memory");
  #undef DMA_K
  #undef DMA_V
  #undef CMASK
  #undef START
  #undef BLOAD
  #undef BSUB
  #undef RESC
  #undef ROT
}
constexpr int ATTN_LDS_BYTES=LDS_BYTES+(SEQ+64)*4;
#undef SBAR
#undef WAIT_BAR
}

namespace cg = cooperative_groups;
constexpr int NWAVES = 8;
#ifndef MK_SINGLE
#define MK_SINGLE 1
#endif
constexpr int NPHASE = 8;
constexpr int RING_BYTES = 131072, LDS_BYTES = 163840, MISC_OFF = LDS_BYTES - 256;

#define GAS __attribute__((address_space(1)))
#define LAS __attribute__((address_space(3)))
typedef unsigned short bf16;
typedef unsigned v4u __attribute__((ext_vector_type(4)));
typedef unsigned v2u __attribute__((ext_vector_type(2)));
typedef float f32x4 __attribute__((ext_vector_type(4)));
#define LDS_WAIT() asm volatile("s_waitcnt lgkmcnt(0)" ::: "memory")
__device__ __forceinline__ unsigned f2bf(float f) { unsigned u = __builtin_bit_cast(unsigned, f); return (u + 0x7fffu + ((u >> 16) & 1u)) >> 16; }
__device__ __forceinline__ unsigned pk2(float lo, float hi) { return f2bf(lo) | (f2bf(hi) << 16); }
__device__ __forceinline__ float wave_sum(float v) {
#pragma unroll
    for (int o = 1; o < 64; o <<= 1) v += __shfl_xor(v, o);
    return v;
}
__device__ __forceinline__ float row16_sum(float x) {
    x += __builtin_bit_cast(float, __builtin_amdgcn_update_dpp(0, __builtin_bit_cast(int, x), 0xB1, 0xF, 0xF, false));
    x += __builtin_bit_cast(float, __builtin_amdgcn_update_dpp(0, __builtin_bit_cast(int, x), 0x4E, 0xF, 0xF, false));
    x += __builtin_bit_cast(float, __builtin_amdgcn_update_dpp(0, __builtin_bit_cast(int, x), 0x141, 0xF, 0xF, false));
    x += __builtin_bit_cast(float, __builtin_amdgcn_update_dpp(0, __builtin_bit_cast(int, x), 0x140, 0xF, 0xF, false));
    return x;
}

typedef GAS unsigned gu32;
#define RLX_AGENT __ATOMIC_RELAXED, __HIP_MEMORY_SCOPE_AGENT
#define XB_TMO      128
#define XB_XCNT(j)  (256  + 64 * (j))
#define XB_XSUB(j)  (1280 + 64 * (j))
#define XB_XGEN(j)  (2304 + 64 * (j))
#define XB_TOP      3328
#define XB_TOPGEN   3392
#define XCD_BAR_WORDS 3456
#define XB_SPIN_CAP (1u << 18)

__device__ __forceinline__ unsigned xb_ld(unsigned* p)              { return __hip_atomic_load(p, __ATOMIC_RELAXED, __HIP_MEMORY_SCOPE_AGENT); }
__device__ __forceinline__ unsigned xb_add(unsigned* p, unsigned v) { return __hip_atomic_fetch_add(p, v, __ATOMIC_RELAXED, __HIP_MEMORY_SCOPE_AGENT); }
__device__ __forceinline__ unsigned xb_xcc_id() { return (unsigned)__builtin_amdgcn_s_getreg((3 << 11) | 20) & 0xFu; }
#define XB_SPIN(cond, bar) do { unsigned _sp = 0; while (cond) { __builtin_amdgcn_s_sleep(1); \
    if ((++_sp & 255u) == 0u) { if (xb_ld(&(bar)[XB_TMO])) break; if (_sp > XB_SPIN_CAP) { atomicAdd(&(bar)[XB_TMO], 1u); break; } } } } while (0)

struct XcdBarrier {
    unsigned* bar; unsigned x;
    volatile LAS unsigned* st;
};

__device__ __forceinline__ XcdBarrier xcd_barrier_post(unsigned* bar, volatile LAS unsigned* st) {
    XcdBarrier b; b.bar = bar; b.x = xb_xcc_id(); b.st = st;
    if (threadIdx.x == 0) (void)xb_add(&bar[XB_XCNT(b.x)], 1u);
    return b;
}
__device__ __forceinline__ void xcd_barrier_complete(unsigned* bar, unsigned x, unsigned& nloc, unsigned& nx) {
    const unsigned G = gridDim.x * gridDim.y * gridDim.z;
    unsigned sum, cnt, mine, sp = 0u;
    for (;;) {
        sum = 0u; cnt = 0u; mine = 0u;
#pragma unroll
        for (unsigned j = 0; j < 16; ++j) { const unsigned c = xb_ld(&bar[XB_XCNT(j)]); sum += c; cnt += (c > 0u) ? 1u : 0u; mine = (j == x) ? c : mine; }
        if (sum == G) break;
        __builtin_amdgcn_s_sleep(1);
        if ((++sp & 255u) == 0u) { if (xb_ld(&bar[XB_TMO])) break; if (sp > XB_SPIN_CAP) { atomicAdd(&bar[XB_TMO], 1u); break; } }
    }
    nloc = mine > 0u ? mine : 1u; nx = cnt > 0u ? cnt : 1u;
}

__device__ __forceinline__ void xcd_barrier(const XcdBarrier& b, int tid_now) {
    asm volatile("s_waitcnt vmcnt(0)" ::: "memory");
    __syncthreads();
    if (tid_now == 0) {
        unsigned* bar = b.bar;
        __builtin_amdgcn_s_waitcnt(0);
        unsigned nloc = b.st[0], nx = b.st[1];
        if (nloc == 0u) { xcd_barrier_complete(bar, b.x, nloc, nx); b.st[0] = nloc; b.st[1] = nx; }
        const unsigned old = xb_add(&bar[XB_XSUB(b.x)], 1u);
        const unsigned gen = old / nloc;
        if (old + 1u == (gen + 1u) * nloc) {
            __builtin_amdgcn_fence(__ATOMIC_RELEASE, "agent");
            asm volatile("s_waitcnt vmcnt(0)" ::: "memory");
            const unsigned og = xb_add(&bar[XB_TOP], 1u);
            const unsigned tg = og / nx;
            if (og + 1u == (tg + 1u) * nx) xb_add(&bar[XB_TOPGEN], 1u);
            else XB_SPIN(xb_ld(&bar[XB_TOPGEN]) == tg, bar);
            __builtin_amdgcn_fence(__ATOMIC_ACQUIRE, "agent");
            xb_add(&bar[XB_XGEN(b.x)], 1u);
            asm volatile("s_waitcnt vmcnt(0)" ::: "memory");
        } else {
            XB_SPIN(xb_ld(&bar[XB_XGEN(b.x)]) == gen, bar);
            __builtin_amdgcn_fence(__ATOMIC_ACQUIRE, "agent");
            asm volatile("s_waitcnt vmcnt(0)" ::: "memory");
        }
    }
    __syncthreads();
}

__device__ __forceinline__ int lane_now() { int l; asm volatile("v_mbcnt_lo_u32_b32 %0, -1, 0\n\tv_mbcnt_hi_u32_b32 %0, -1, %0" : "=v"(l)); return l; }
struct Args { const float* in[19]; float* out; unsigned char* ws; int ph_lo, ph_hi, flags, pad; };

__device__ __forceinline__ void p0_transpose_item(const float* W, int K, int ldw, int sc0, int ncols, int nvalid, bf16* WT, int dr0, LAS float* scr, int item, int lane) {
    const int nblk = ncols / 32, kb = item / nblk, nb = item % nblk, k0 = 64 * kb, n0 = 32 * nb;
    const bool ok = (n0 + (lane & 31)) < nvalid;
    float tv[32];
    const float* wp = W + (size_t)(k0 + (lane >> 5)) * ldw + sc0 + n0 + (lane & 31);
#pragma unroll
    for (int i = 0; i < 32; ++i) tv[i] = ok ? wp[(size_t)(2 * i) * ldw] : 0.f;
#pragma unroll
    for (int i = 0; i < 32; ++i) scr[(2 * i + (lane >> 5)) * 33 + (lane & 31)] = tv[i];
    LDS_WAIT(); asm volatile("" ::: "memory");
    const int c = lane & 7;
#pragma unroll
    for (int j = 0; j < 4; ++j) { const int n = (lane >> 3) + 8 * j; const LAS float* s = scr + (8 * c) * 33 + n;
        v4u o; o.x = pk2(s[0 * 33], s[1 * 33]); o.y = pk2(s[2 * 33], s[3 * 33]); o.z = pk2(s[4 * 33], s[5 * 33]); o.w = pk2(s[6 * 33], s[7 * 33]);
        *(GAS v4u*)(WT + (size_t)(dr0 + n0 + n) * K + k0 + 8 * c) = o; }
    LDS_WAIT(); asm volatile("" ::: "memory");
}
__device__ __forceinline__ void rms_row_to_bf16(const float* xrow, const float* g, bf16* orow, int lane) {
    const GAS f32x4* xr = (const GAS f32x4*)xrow + lane; const GAS f32x4* gr = (const GAS f32x4*)g + lane;
    f32x4 v[16]; float s = 0.f;
#pragma unroll
    for (int j = 0; j < 16; ++j) { v[j] = xr[64 * j]; s += (v[j].x * v[j].x + v[j].y * v[j].y) + (v[j].z * v[j].z + v[j].w * v[j].w); }
    const float rstd = 1.0f / sqrtf(wave_sum(s) * (1.f / DMODEL) + RMS_EPS);
    GAS unsigned long long* o8 = (GAS unsigned long long*)orow + lane;
#pragma unroll
    for (int j = 0; j < 16; ++j) { const f32x4 gg = gr[64 * j]; const f32x4 y = v[j] * rstd * gg;
        o8[64 * j] = (unsigned long long)pk2(y.x, y.y) | ((unsigned long long)pk2(y.z, y.w) << 32); }
}

__device__ __forceinline__ void phase_prologue(const Args& A, LAS unsigned char* lds, int gw, int NGW, int wave, int lane) {
    unsigned char* ws = A.ws;
    LAS float* scr = (LAS float*)(lds + wave * 16384);
    const float* w_in = A.in[3]; const float* w_dec = A.in[6]; const float* w_icl = A.in[8]; const float* w_mkv = A.in[16]; const float* w_out = A.in[17];
    bf16* WinT = (bf16*)(ws + WS_WIN); bf16* WoT = (bf16*)(ws + WS_WO); bf16* WmT = (bf16*)(ws + WS_WM); bf16* WdT = (bf16*)(ws + WS_WD); bf16* WiT = WdT + 1536 * 128;
    (void)scr;
    {
        constexpr int NB_IN = NPAD / 256, I_IN = 32 * NB_IN, I_O = 32 * 16, I_M = 32 * 8, I_D = 6;
        constexpr int NITEMS = I_IN + I_O + I_M + 2 * I_D;
        const int tid = wave * 64 + lane; const int G_ = NGW / NWAVES, blk = gw / NWAVES;
        LAS float* tile = (LAS float*)lds;
        f32x4 cur[16];
#define P0_DECODE(it, SRC, LDW, NVALID, DST, KDST) do { int r_ = (it); \
            if (r_ < I_IN) { const int nb = r_ % NB_IN, kb = r_ / NB_IN; const int sc = nb < 19 ? 256 * nb : nb == 19 ? 11008 : nb < 44 ? 4864 + 256 * (nb - 20) : 11032 + 256 * (nb - 44); \
                SRC = w_in + (size_t)(128 * kb) * IN_W + sc; LDW = IN_W; NVALID = nb == 19 ? 24 : 256; DST = WinT + (size_t)(256 * nb) * DMODEL + 128 * kb; KDST = DMODEL; } \
            else if ((r_ -= I_IN) < I_O) { const int nb = r_ % 16, kb = r_ / 16; SRC = w_out + (size_t)(128 * kb) * DMODEL + 256 * nb; LDW = DMODEL; NVALID = 256; DST = WoT + (size_t)(256 * nb) * DMODEL + 128 * kb; KDST = DMODEL; } \
            else if ((r_ -= I_O) < I_M) { const int nb = r_ % 8, kb = r_ / 8; SRC = w_mkv + (size_t)(128 * kb) * 2048 + 256 * nb; LDW = 2048; NVALID = 256; DST = WmT + (size_t)(256 * nb) * DMODEL + 128 * kb; KDST = DMODEL; } \
            else if ((r_ -= I_M) < I_D) { SRC = w_dec + 256 * r_; LDW = RW; NVALID = 256; DST = WdT + (size_t)(256 * r_) * LORA; KDST = LORA; } \
            else { r_ -= I_D; SRC = w_icl + 256 * r_; LDW = RW; NVALID = 256; DST = WiT + (size_t)(256 * r_) * LORA; KDST = LORA; } } while (0)
        const float* src = nullptr; int ldw = 0, nvalid = 0; bf16* dst = nullptr; int kdst = 0;
        int it = blk;
        if (it < NITEMS) { P0_DECODE(it, src, ldw, nvalid, dst, kdst);
#pragma unroll
            for (int i = 0; i < 16; ++i) cur[i] = __builtin_nontemporal_load((const f32x4*)(src + (size_t)(wave * 16 + i) * ldw + 4 * lane));     }
        while (it < NITEMS) {
            const bool zero = 4 * lane >= nvalid;
#pragma unroll
            for (int i = 0; i < 16; ++i) *(LAS f32x4*)(tile + (wave * 16 + i) * 260 + 4 * lane) = zero ? (f32x4){0.f, 0.f, 0.f, 0.f} : cur[i];
            bf16* dcur = dst; const int kcur = kdst;
            const int nx = it + G_;
            if (nx < NITEMS) { P0_DECODE(nx, src, ldw, nvalid, dst, kdst);
#pragma unroll
                for (int i = 0; i < 16; ++i) cur[i] = __builtin_nontemporal_load((const f32x4*)(src + (size_t)(wave * 16 + i) * ldw + 4 * lane));     }
            LDS_WAIT(); __syncthreads();
            { const int n = wave * 32 + (lane & 31);
#pragma unroll
              for (int i = 0; i < 8; ++i) { const int c = (lane >> 5) + 2 * i; const LAS float* tp = tile + (8 * c) * 260 + n;
                  v4u o; o.x = pk2(tp[0], tp[260]); o.y = pk2(tp[2 * 260], tp[3 * 260]); o.z = pk2(tp[4 * 260], tp[5 * 260]); o.w = pk2(tp[6 * 260], tp[7 * 260]);
                  *(GAS v4u*)(dcur + (size_t)n * kcur + 8 * c) = o; } }
            LDS_WAIT(); __syncthreads();
            it = nx;
        }
#undef P0_DECODE
        (void)tid;
    }
    const float* x = A.in[0]; const float* mem = A.in[1];
    bf16* H = (bf16*)(ws + WS_H); bf16* MEMN = (bf16*)(ws + WS_MEMN);
    for (int m = gw; m < M + 512; m += 2 * NGW) {
        const int m2 = m + NGW; const bool has2 = m2 < M + 512;
        const float* r1 = m < M ? x + (size_t)m * DMODEL : mem + (size_t)(m - M) * DMODEL; const float* g1 = m < M ? A.in[2] : A.in[15]; bf16* o1 = m < M ? H + (size_t)m * DMODEL : MEMN + (size_t)(m - M) * DMODEL;
        const int mb = has2 ? m2 : m;
        const float* r2 = mb < M ? x + (size_t)mb * DMODEL : mem + (size_t)(mb - M) * DMODEL; const float* g2 = mb < M ? A.in[2] : A.in[15]; bf16* o2 = mb < M ? H + (size_t)mb * DMODEL : MEMN + (size_t)(mb - M) * DMODEL;
        const GAS f32x4* x1 = (const GAS f32x4*)r1 + lane; const GAS f32x4* x2 = (const GAS f32x4*)r2 + lane;
        f32x4 va[16], vb[16]; float s1 = 0.f, s2 = 0.f;
#pragma unroll
        for (int j = 0; j < 16; ++j) va[j] = __builtin_nontemporal_load(&x1[64 * j]);
#pragma unroll
        for (int j = 0; j < 16; ++j) vb[j] = __builtin_nontemporal_load(&x2[64 * j]);
#pragma unroll
        for (int j = 0; j < 16; ++j) { s1 += (va[j].x * va[j].x + va[j].y * va[j].y) + (va[j].z * va[j].z + va[j].w * va[j].w); s2 += (vb[j].x * vb[j].x + vb[j].y * vb[j].y) + (vb[j].z * vb[j].z + vb[j].w * vb[j].w); }
        const float rs1 = 1.0f / sqrtf(wave_sum(s1) * (1.f / DMODEL) + RMS_EPS), rs2 = 1.0f / sqrtf(wave_sum(s2) * (1.f / DMODEL) + RMS_EPS);
        const GAS f32x4* ga = (const GAS f32x4*)g1 + lane; const GAS f32x4* gb = (const GAS f32x4*)g2 + lane;
        GAS unsigned long long* oa = (GAS unsigned long long*)o1 + lane; GAS unsigned long long* ob = (GAS unsigned long long*)o2 + lane;
#pragma unroll
        for (int j = 0; j < 16; ++j) { const f32x4 y = va[j] * rs1 * ga[64 * j]; oa[64 * j] = (unsigned long long)pk2(y.x, y.y) | ((unsigned long long)pk2(y.z, y.w) << 32); }
        if (has2) {
#pragma unroll
            for (int j = 0; j < 16; ++j) { const f32x4 y = vb[j] * rs2 * gb[64 * j]; ob[64 * j] = (unsigned long long)pk2(y.x, y.y) | ((unsigned long long)pk2(y.z, y.w) << 32); } }
    }
}

__device__ __forceinline__ void phase_shift_cum(const Args& A, int gtid, int NGT, int gw, int lane) {
    unsigned char* ws = A.ws;
    const float* WA = (const float*)(ws + WS_WA); const float* mu = A.in[4];
    bf16* A1 = (bf16*)(ws + WS_A1); bf16* A2 = A1 + (size_t)M * LORA;
    for (int e = gtid; e < M * 64; e += NGT) {
        const int m = e >> 6, c4 = (e & 63) * 4; const int t = m & (T - 1);
        const f32x4 cur = *(const f32x4*)(WA + (size_t)m * 256 + c4);
        const f32x4 prv = t ? *(const f32x4*)(WA + (size_t)(m - 1) * 256 + c4) : (f32x4){0.f, 0.f, 0.f, 0.f};
        const f32x4 mm = *(const f32x4*)(mu + 4608 + c4);
        f32x4 v = cur + (prv - cur) * mm;
        if (c4 < 128) { v.x = tanhf(v.x); v.y = tanhf(v.y); v.z = tanhf(v.z); v.w = tanhf(v.w);
            *(v2u*)(A1 + (size_t)m * LORA + c4) = (v2u){pk2(v.x, v.y), pk2(v.z, v.w)}; }
        else *(v2u*)(A2 + (size_t)m * LORA + (c4 - 128)) = (v2u){pk2(v.x, v.y), pk2(v.z, v.w)};
    }
    const float* FL = (const float*)(ws + WS_FL); const float* b_f = A.in[14]; float* CUM = (float*)(ws + WS_CUM);
    if (gw < BATCH * NH) {
        const int b = gw / NH, h = gw % NH; const float bf = b_f[h];
        const float* src = FL + ((size_t)b * T + lane * 64) * 256 + h; float zv[64];
#pragma unroll
        for (int i = 0; i < 64; ++i) zv[i] = src[(size_t)i * 256];
        float loc = 0.f;
#pragma unroll
        for (int i = 0; i < 64; ++i) { const float z = zv[i] + bf; loc += fminf(z, 0.f) - 0.6931471805599453f * __builtin_amdgcn_logf(1.0f + __builtin_amdgcn_exp2f(-1.4426950408889634f * fabsf(z))); zv[i] = loc; }
        float incl = loc;
#pragma unroll
        for (int o = 1; o < 64; o <<= 1) { const float n = __shfl_up(incl, o); if (lane >= o) incl += n; }
        const float off = incl - loc; float* dst = CUM + (size_t)gw * T + lane * 64;
#pragma unroll
        for (int i = 0; i < 64; i += 4) *(f32x4*)(dst + i) = (f32x4){zv[i] + off, zv[i + 1] + off, zv[i + 2] + off, zv[i + 3] + off};
    }
}

constexpr int SC_TC = 32, SC_STEP_F = 256, SC_V_OFF = SC_TC * SC_STEP_F, SC_G_OFF = SC_V_OFF + SC_TC * 32, SC_BUF_F = SC_G_OFF + 64;
constexpr int SC_YS = 68;
constexpr int SC_Y_OFF_F = 2 * SC_BUF_F;
typedef float f32x2s __attribute__((ext_vector_type(2)));
__device__ __forceinline__ float sc_fma(float a, float b, float c) { float r; asm("v_fma_f32 %0, %1, %2, %3" : "=v"(r) : "v"(a), "v"(b), "v"(c)); return r; }
__device__ __forceinline__ float sc_mul(float a, float b) { float r; asm("v_mul_f32_e32 %0, %1, %2" : "=v"(r) : "v"(a), "v"(b)); return r; }
struct ScanRegs { f32x4 r0, r1, k0, k1, w, al, e; float v0a, v1a, v0b, v1b; };
__device__ __forceinline__ void scan_load(ScanRegs& g, const unsigned char* ws, int b, int h, int half, int c, int tid) {
    const float* R = (const float*)(ws + WS_R); const float* Kr = R + (size_t)M * RW; const float* Vr = Kr + (size_t)M * RW;
    const float* DEC = (const float*)(ws + WS_DEC); const float* ALP = DEC + (size_t)M * RW; const float* GAME = (const float*)(ws + WS_GAME);
    const int jq = tid & 15, col = h * HD + 4 * jq, tl = tid >> 4, t = c * SC_TC + tl; const size_t m = (size_t)b * T + t;
    const f32x4 z4 = (f32x4){0.f, 0.f, 0.f, 0.f};
    g.r0 = *(const f32x4*)(R + m * RW + col); g.k0 = *(const f32x4*)(Kr + m * RW + col);
    g.r1 = t ? *(const f32x4*)(R + (m - 1) * RW + col) : z4; g.k1 = t ? *(const f32x4*)(Kr + (m - 1) * RW + col) : z4;
    g.w = *(const f32x4*)(DEC + m * RW + col); g.al = *(const f32x4*)(ALP + m * RW + col); g.e = *(const f32x4*)(GAME + m * RW + col);
    const int vcol = h * HD + 32 * half + jq;
    g.v0a = Vr[m * RW + vcol]; g.v0b = Vr[m * RW + vcol + 16];
    g.v1a = t ? Vr[(m - 1) * RW + vcol] : 0.f; g.v1b = t ? Vr[(m - 1) * RW + vcol + 16] : 0.f;
}
struct ScanConst { f32x4 mu_r, mu_k, kk_w, ka_w, rk_w; float mu_va, mu_vb; };
__device__ __forceinline__ void scan_store(const ScanRegs& g, const ScanConst& K, const Args& A, LAS float* buf, int b, int h, int half, int c, int tid) {
    const int jq = tid & 15, tl = tid >> 4, t = c * SC_TC + tl; const size_t m = (size_t)b * T + t;
    const f32x4 mu_r = K.mu_r, mu_k = K.mu_k, kk_w = K.kk_w, ka_w = K.ka_w, rk_w = K.rk_w; const float mu_va = K.mu_va, mu_vb = K.mu_vb;
    const f32x4 rs = g.r0 + (g.r1 - g.r0) * mu_r, ks = g.k0 + (g.k1 - g.k0) * mu_k;
    f32x4 kk = ks * kk_w;
    const float ss = row16_sum((kk.x * kk.x + kk.y * kk.y) + (kk.z * kk.z + kk.w * kk.w));
    kk = kk * __builtin_amdgcn_rsqf(fmaxf(ss, 1e-24f));
    const f32x4 km = ks * (1.0f + (g.al - 1.0f) * ka_w);
    const f32x4 rkk = rs * km * rk_w;
    const float cf = row16_sum((rkk.x + rkk.y) + (rkk.z + rkk.w));
    if (half == 0 && jq == 0) ((float*)(A.ws + WS_COEF))[m * NH + h] = cf;
    const f32x4 gt = g.e * g.w;
    f32x4 inv; inv.x = __builtin_amdgcn_rcpf(gt.x); inv.y = __builtin_amdgcn_rcpf(gt.y); inv.z = __builtin_amdgcn_rcpf(gt.z); inv.w = __builtin_amdgcn_rcpf(gt.w);
    LAS float* st = buf + tl * SC_STEP_F + 4 * jq;
    *(LAS f32x4*)(st) = -(kk * g.e); *(LAS f32x4*)(st + 64) = kk * g.al * inv; *(LAS f32x4*)(st + 128) = km * inv; *(LAS f32x4*)(st + 192) = rs * gt;
    if (tl == SC_TC - 1) *(LAS f32x4*)(buf + SC_G_OFF + 4 * jq) = gt;
    buf[SC_V_OFF + tl * 32 + jq] = g.v0a + (g.v1a - g.v0a) * mu_va; buf[SC_V_OFF + tl * 32 + jq + 16] = g.v0b + (g.v1b - g.v0b) * mu_vb;
}
__device__ __forceinline__ void scan_unit(const Args& A, LAS unsigned char* lds, int s, int tid) {
    const int bh = s >> 1, half = s & 1, b = bh / NH, h = bh % NH;
    const int wave = __builtin_amdgcn_readfirstlane(tid >> 6), lane = tid & 63;
    LAS float* buf0 = (LAS float*)lds; LAS float* buf1 = buf0 + SC_BUF_F; LAS float* yb = buf0 + SC_Y_OFF_F + wave * (SC_TC * SC_YS);
    float* Y = (float*)(A.ws + WS_Y);
    const int jq = lane & 15, rl = wave * 4 + (lane >> 4);
    float S0 = 0.f, S1 = 0.f, S2 = 0.f, S3 = 0.f;
    ScanRegs g; ScanConst K;
    { const float* mu = A.in[4]; const int col = h * HD + 4 * jq, vcol = h * HD + 32 * half + jq;
      K.mu_r = *(const f32x4*)(mu + col); K.mu_k = *(const f32x4*)(mu + RW + col); K.kk_w = *(const f32x4*)(A.in[9] + col); K.ka_w = *(const f32x4*)(A.in[10] + col); K.rk_w = *(const f32x4*)(A.in[11] + col);
      K.mu_va = mu[2 * RW + vcol]; K.mu_vb = mu[2 * RW + vcol + 16]; }
    scan_load(g, A.ws, b, h, half, 0, tid); scan_store(g, K, A, buf0, b, h, half, 0, tid);
    LDS_WAIT(); __builtin_amdgcn_s_barrier(); asm volatile("" ::: "memory");
    constexpr int NCH = T / SC_TC;
    for (int c = 0; c < NCH; ++c) {
        LAS float* cur = (c & 1) ? buf1 : buf0; LAS float* nxt = (c & 1) ? buf0 : buf1;
        if (c + 1 < NCH) scan_load(g, A.ws, b, h, half, c + 1, tid);
        {
            const LAS float* st = cur + 4 * jq; const LAS float* vp = cur + SC_V_OFF + rl;
            f32x4 a = *(const LAS f32x4*)(st), bb = *(const LAS f32x4*)(st + 64), k = *(const LAS f32x4*)(st + 128), r = *(const LAS f32x4*)(st + 192);
            float v = vp[0];
            f32x4 a1 = *(const LAS f32x4*)(st + SC_STEP_F), bb1 = *(const LAS f32x4*)(st + SC_STEP_F + 64), k1 = *(const LAS f32x4*)(st + SC_STEP_F + 128), r1 = *(const LAS f32x4*)(st + SC_STEP_F + 192);
            float v1 = vp[32];
            f32x4 pr = (f32x4){0.f, 0.f, 0.f, 0.f};
#pragma unroll
            for (int tl = 0; tl < SC_TC; ++tl) {
                float sa, yy;
                asm volatile(
                    "v_mul_f32_e32 %0, %2, %6\n\t"
                    "v_mul_f32_e32 %1, %2, %10\n\t"
                    "v_fmac_f32_e32 %0, %3, %7\n\t"
                    "v_fmac_f32_e32 %1, %3, %11\n\t"
                    "v_fmac_f32_e32 %0, %4, %8\n\t"
                    "v_fmac_f32_e32 %1, %4, %12\n\t"
                    "v_fmac_f32_e32 %0, %5, %9\n\t"
                    "v_fmac_f32_e32 %1, %5, %13\n\t"
                    "v_fmac_f32_e32 %2, %18, %14\n\t"
                    "v_add_f32_dpp %0, %0, %0 quad_perm:[1,0,3,2] row_mask:0xf bank_mask:0xf\n\t"
                    "v_fmac_f32_e32 %3, %18, %15\n\t"
                    "v_fmac_f32_e32 %4, %18, %16\n\t"
                    "v_add_f32_dpp %0, %0, %0 quad_perm:[2,3,0,1] row_mask:0xf bank_mask:0xf\n\t"
                    "v_fmac_f32_e32 %5, %18, %17\n\t"
                    "s_nop 0\n\t"
                    "v_add_f32_dpp %0, %0, %0 row_half_mirror row_mask:0xf bank_mask:0xf\n\t"
                    : "=&v"(sa), "=&v"(yy), "+v"(S0), "+v"(S1), "+v"(S2), "+v"(S3)
                    : "v"(a.x), "v"(a.y), "v"(a.z), "v"(a.w), "v"(pr.x), "v"(pr.y), "v"(pr.z), "v"(pr.w), "v"(k.x), "v"(k.y), "v"(k.z), "v"(k.w), "v"(v));
                if (tl > 0) yb[(tl - 1) * SC_YS + lane] = yy;
                const f32x4 b_now = bb; pr = r;
                a = a1; bb = bb1; k = k1; r = r1; v = v1;
                if (tl + 2 < SC_TC) { const LAS float* sn = st + (tl + 2) * SC_STEP_F;
                    a1 = *(const LAS f32x4*)(sn); bb1 = *(const LAS f32x4*)(sn + 64); k1 = *(const LAS f32x4*)(sn + 128); r1 = *(const LAS f32x4*)(sn + 192); v1 = vp[(tl + 2) * 32]; }
                __builtin_amdgcn_sched_barrier(0);
                if (tl + 2 >= SC_TC) asm volatile("s_nop 1");
                asm volatile(
                    "v_add_f32_dpp %4, %4, %4 row_mirror row_mask:0xf bank_mask:0xf\n\t"
                    "v_fmac_f32_e32 %0, %4, %5\n\t"
                    "v_fmac_f32_e32 %1, %4, %6\n\t"
                    "v_fmac_f32_e32 %2, %4, %7\n\t"
                    "v_fmac_f32_e32 %3, %4, %8\n\t"
                    : "+v"(S0), "+v"(S1), "+v"(S2), "+v"(S3), "+v"(sa)
                    : "v"(b_now.x), "v"(b_now.y), "v"(b_now.z), "v"(b_now.w));
            }
            { float yy = sc_mul(S0, pr.x); yy = sc_fma(S1, pr.y, yy); yy = sc_fma(S2, pr.z, yy); yy = sc_fma(S3, pr.w, yy); yb[(SC_TC - 1) * SC_YS + lane] = yy; }
            { const f32x4 ge = *(const LAS f32x4*)(cur + SC_G_OFF + 4 * jq); S0 = sc_mul(S0, ge.x); S1 = sc_mul(S1, ge.y); S2 = sc_mul(S2, ge.z); S3 = sc_mul(S3, ge.w); }
        }
        if (c + 1 < NCH) scan_store(g, K, A, nxt, b, h, half, c + 1, tid);
        {
            LDS_WAIT();
            const LAS f32x4* yp = (const LAS f32x4*)(yb + (lane & 31) * SC_YS + (lane >> 5) * 32);
            f32x4 s0 = yp[0] + yp[1] + (yp[2] + yp[3]), s1 = yp[4] + yp[5] + (yp[6] + yp[7]);
            f32x2s o = (f32x2s){(s0.x + s0.y) + (s0.z + s0.w), (s1.x + s1.y) + (s1.z + s1.w)};
            *(f32x2s*)(Y + ((size_t)b * T + c * SC_TC + (lane & 31)) * RW + h * HD + 32 * half + wave * 4 + (lane >> 5) * 2) = o;
        }
        LDS_WAIT(); __builtin_amdgcn_s_barrier(); asm volatile("" ::: "memory");
    }
}

__device__ __forceinline__ void phase_rwkv_out(const Args& A, int gtid, int NGT) {
    unsigned char* ws = A.ws;
    const float* Y = (const float*)(ws + WS_Y); const float* Vr = (const float*)(ws + WS_R) + (size_t)2 * M * RW; const float* COEF = (const float*)(ws + WS_COEF);
    const bf16* G = (const bf16*)(ws + WS_G); bf16* YC = (bf16*)(ws + WS_YC);
    const float* mu = A.in[4]; const float* lnw = A.in[12]; const float* lnb = A.in[13];
    for (int e0 = gtid; e0 < M * (RW / 4); e0 += 4 * NGT) {
        f32x4 y[4], v0[4], v1[4]; v2u gw[4]; float cf[4]; int mm[4], cc[4]; bool ok[4];
#pragma unroll
        for (int q = 0; q < 4; ++q) { const int e = e0 + q * NGT; ok[q] = e < M * (RW / 4); const int ee = ok[q] ? e : e0;
            const int m = ee / (RW / 4), c4 = (ee % (RW / 4)) * 4, h = c4 >> 6; const int t = m & (T - 1); mm[q] = m; cc[q] = c4;
            y[q] = __builtin_nontemporal_load((const f32x4*)(Y + (size_t)m * RW + c4));
            v0[q] = *(const f32x4*)(Vr + (size_t)m * RW + c4); v1[q] = t ? *(const f32x4*)(Vr + (size_t)(m - 1) * RW + c4) : (f32x4){0.f, 0.f, 0.f, 0.f};
            cf[q] = COEF[(size_t)m * NH + h]; gw[q] = __builtin_nontemporal_load((const v2u*)(G + (size_t)m * 4096 + c4)); }
#pragma unroll
        for (int q = 0; q < 4; ++q) { const int m = mm[q], c4 = cc[q];
            const float mean = row16_sum((y[q].x + y[q].y) + (y[q].z + y[q].w)) * (1.f / 64.f);
            const f32x4 d = y[q] - mean;
            const float var = row16_sum((d.x * d.x + d.y * d.y) + (d.z * d.z + d.w * d.w)) * (1.f / 64.f);
            const float rstd = 1.0f / sqrtf(var + GN_EPS);
            const f32x4 vs = v0[q] + (v1[q] - v0[q]) * *(const f32x4*)(mu + 2 * RW + c4);
            f32x4 o = d * rstd * *(const f32x4*)(lnw + c4) + *(const f32x4*)(lnb + c4) + cf[q] * vs;
            const float g0 = __uint_as_float(gw[q].x << 16), g1 = __uint_as_float(gw[q].x & 0xffff0000u), g2 = __uint_as_float(gw[q].y << 16), g3 = __uint_as_float(gw[q].y & 0xffff0000u);
            o.x *= g0 / (1.f + __expf(-g0)); o.y *= g1 / (1.f + __expf(-g1)); o.z *= g2 / (1.f + __expf(-g2)); o.w *= g3 / (1.f + __expf(-g3));
            if (ok[q]) *(v2u*)(YC + (size_t)m * 4096 + c4) = (v2u){pk2(o.x, o.y), pk2(o.z, o.w)}; }
    }
}
__device__ __forceinline__ void phase_final(const Args& A, int gw, int NGW, int lane) {
    const bf16* YO = (const bf16*)(A.ws + WS_YO); const float* x = A.in[0]; const float* g = A.in[18];
    for (int m = gw; m < M; m += NGW) {
        const GAS v2u* yr = (const GAS v2u*)(YO + (size_t)m * DMODEL) + lane; const GAS f32x4* xr = (const GAS f32x4*)(x + (size_t)m * DMODEL) + lane;
        const GAS f32x4* gr = (const GAS f32x4*)g + lane; GAS f32x4* orow = (GAS f32x4*)(A.out + (size_t)m * DMODEL) + lane;
        f32x4 v[16], xv[16]; float s = 0.f;
#pragma unroll
        for (int j = 0; j < 16; ++j) xv[j] = __builtin_nontemporal_load(&xr[64 * j]);
#pragma unroll
        for (int j = 0; j < 16; ++j) { const v2u q = __builtin_nontemporal_load(&yr[64 * j]); v[j] = (f32x4){__uint_as_float(q.x << 16), __uint_as_float(q.x & 0xffff0000u), __uint_as_float(q.y << 16), __uint_as_float(q.y & 0xffff0000u)}; s += (v[j].x * v[j].x + v[j].y * v[j].y) + (v[j].z * v[j].z + v[j].w * v[j].w); }
        const float rstd = 1.0f / sqrtf(wave_sum(s) * (1.f / DMODEL) + RMS_EPS);
#pragma unroll
        for (int j = 0; j < 16; ++j) __builtin_nontemporal_store(xv[j] + v[j] * rstd * gr[64 * j], &orow[64 * j]);
    }
}

__global__ void __launch_bounds__(NWAVES * 64, 2) hybrid_fwd(Args A) {
    extern __shared__ __attribute__((aligned(16))) unsigned char lds_raw[];
    LAS unsigned char* lds = (LAS unsigned char*)lds_raw;
    volatile LAS unsigned* MISC = (volatile LAS unsigned*)(lds + MISC_OFF);
    const int wave0 = __builtin_amdgcn_readfirstlane(threadIdx.x >> 6);
    const bool multi = (A.ph_hi - A.ph_lo) > 1;
    if (threadIdx.x < 16) MISC[threadIdx.x] = 0u;
    __syncthreads();
    XcdBarrier bar; bar.bar = (unsigned*)(A.ws + WS_CTL) + 4096; bar.x = 0; bar.st = MISC + 8;
    if (multi) { bar = xcd_barrier_post((unsigned*)(A.ws + WS_CTL) + 4096, MISC + 8);
                 cg::this_grid().sync(); }
#define TIDNOW (wave0 * 64 + lane_now())
#define PH_IDS int tid_ = wave0 * 64 + lane_now(); asm volatile("" : "+v"(tid_)); const int tid = tid_, lane = tid & 63, wave = __builtin_amdgcn_readfirstlane(tid >> 6); \
    const int G = gridDim.x, bx = blockIdx.x; const int vcu = (G % 8 == 0) ? (bx % 8) * (G / 8) + bx / 8 : bx; \
    const int gw = vcu * NWAVES + wave, NGW = G * NWAVES, gtid = vcu * (NWAVES * 64) + tid, NGT = G * NWAVES * 64; (void)lane; (void)gw; (void)NGW; (void)gtid; (void)NGT; (void)bx; (void)vcu; \
    unsigned char* ws = A.ws; asm volatile("" : "+s"(ws)); unsigned* ctl = (unsigned*)(ws + WS_CTL); (void)ctl; \
bf16* WinT = (bf16*)(ws + WS_WIN); bf16* H = (bf16*)(ws + WS_H); bf16* WoT = (bf16*)(ws + WS_WO); bf16* WmT = (bf16*)(ws + WS_WM); bf16* WdT = (bf16*)(ws + WS_WD); bf16* WiT = WdT + 1536 * 128; \
    bf16* MEMN = (bf16*)(ws + WS_MEMN); float* R = (float*)(ws + WS_R); float* WAp = (float*)(ws + WS_WA); float* FLp = (float*)(ws + WS_FL); \
    bf16* Gt = (bf16*)(ws + WS_G); bf16* FQ = (bf16*)(ws + WS_FQ); bf16* FK = FQ + (size_t)M * FW; bf16* FV = FK + (size_t)M * FW; bf16* MQh = (bf16*)(ws + WS_MQ); \
    bf16* MKh = (bf16*)(ws + WS_MK); bf16* MVt = MKh + 8 * 65536; bf16* A1 = (bf16*)(ws + WS_A1); bf16* A2 = A1 + (size_t)M * LORA; \
    float* DEC = (float*)(ws + WS_DEC); float* ALP = DEC + (size_t)M * RW; bf16* Pm = (bf16*)(ws + WS_P); bf16* YC = (bf16*)(ws + WS_YC); bf16* YO = (bf16*)(ws + WS_YO);
    const int lo = A.ph_lo, hi = A.ph_hi;
#ifndef PHMASK
#define PHMASK 0xFFF
#endif
#define IN(k) (((PHMASK >> (k)) & 1) && lo <= (k) && (k) < hi)
#define SEAM(k) do { if (IN(k) && IN((k) + 1)) { xcd_barrier(bar, TIDNOW); } } while (0)
    if (IN(0)) { PH_IDS phase_prologue(A, lds, gw, NGW, wave, lane); __syncthreads(); }
    SEAM(0);
    if (IN(1)) { PH_IDS
        { pg8::Gemm g{H, WinT, M, 5888, DMODEL}; pg8::StaticOrder S; S.init(M, 5888, G, bx);
          pg8::EpiIn E{ws, attn_body::C2, 0};
          pg8::gemm_phase<pg8::EpiIn, pg8::StaticOrder, PG8_ALIGN, PG8_SP2>(lds, g, S, E, TIDNOW); }
        { const int e = (G == 256) ? bx - 224 : bx;
          pg8::ListSched S{(e >= 0 && e < 8) ? e : -1, 1 << 20, 8, 0, 4};
          pg8::Gemm g{MEMN, WmT, 512, 1024, DMODEL}; pg8::EpiTileBf16 E{MKh, 0};
          pg8::gemm_phase<pg8::EpiTileBf16, pg8::ListSched, PG8_ALIGN, PG8_SP2>(lds, g, S, E, TIDNOW);
          pg8::ListSched S2{(e >= 8 && e < 16) ? e - 8 : -1, 1 << 20, 8, 0, 2};
          pg8::Gemm g2{WmT + (size_t)1024 * DMODEL, MEMN, 1024, 512, DMODEL}; pg8::EpiTileBf16 E2{MVt, 1};
          pg8::gemm_phase<pg8::EpiTileBf16, pg8::ListSched, PG8_ALIGN, PG8_SP2>(lds, g2, S2, E2, TIDNOW); }
    }
    SEAM(1);
    if (IN(2)) { PH_IDS phase_shift_cum(A, gtid, NGT, gw, lane); }
    SEAM(2);
    if (IN(3)) { PH_IDS
        { pg8::Gemm g{A1, WdT, M, RW, LORA}; pg8::ListSched S{bx, G, 192, 0, 6}; pg8::EpiLora<0> E{DEC, A.in[5]};
          pg8::gemm_phase<pg8::EpiLora<0>, pg8::ListSched, PG8_ALIGN, PG8_SP2>(lds, g, S, E, TIDNOW); }
        {
            __builtin_amdgcn_fence(__ATOMIC_SEQ_CST, "workgroup"); asm volatile("s_waitcnt vmcnt(0)" ::: "memory"); __syncthreads();
            float* GAME = (float*)(ws + WS_GAME); const int t2 = TIDNOW;
            for (int u = bx; u < 192; u += G) { const int pm = u / 6, pn = u % 6;
                for (int i = 0; i < 4; i += 2) { const size_t base = (size_t)(pm * 256 + (t2 >> 6) * 32) * RW + pn * 256 + (t2 & 63) + 64 * i;
                    float wv[32], wu[32];
#pragma unroll
                    for (int t = 0; t < 32; ++t) { wv[t] = __hip_atomic_load(DEC + base + (size_t)t * RW, __ATOMIC_RELAXED, __HIP_MEMORY_SCOPE_AGENT); wu[t] = __hip_atomic_load(DEC + base + 64 + (size_t)t * RW, __ATOMIC_RELAXED, __HIP_MEMORY_SCOPE_AGENT); }
                    float gq = 1.f, gu = 1.f;
#pragma unroll
                    for (int t = 0; t < 32; ++t) { __builtin_nontemporal_store(gq, &GAME[base + (size_t)t * RW]); gq *= wv[t]; __builtin_nontemporal_store(gu, &GAME[base + 64 + (size_t)t * RW]); gu *= wu[t]; } } }
        }
        { pg8::Gemm g{A2, WiT, M, RW, LORA}; pg8::ListSched S{(G == 256) ? (bx >= 192 ? bx - 192 : -1) : bx, (G == 256) ? 64 : G, 192, 0, 6}; pg8::EpiLora<1> E{ALP, A.in[7]};
          pg8::gemm_phase<pg8::EpiLora<1>, pg8::ListSched, PG8_ALIGN, PG8_SP2>(lds, g, S, E, TIDNOW); }
    }
    SEAM(3);
    if (IN(4)) { PH_IDS
        int sidx = -1;
        if (G >= 256) { if ((vcu & 31) < 12 && vcu < 256) sidx = (vcu >> 5) * 12 + (vcu & 31); }
        if (!(A.flags & 1)) {
            if (sidx >= 0) scan_unit(A, lds, sidx, tid);
            else if (G < 256) { for (int s = bx; s < 96; s += G) scan_unit(A, lds, s, tid); }
        }
        if (!(A.flags & 2)) {
            __syncthreads();
            pg8::Gemm g{H, WinT + (size_t)5888 * DMODEL, M, 8960, DMODEL}; pg8::QueueSched S{ctl + 128, (volatile LAS unsigned*)(MISC + 16), 32 * 35, 35, wave0};
            pg8::EpiIn E{ws, attn_body::C2, 23};
            pg8::gemm_phase<pg8::EpiIn, pg8::QueueSched, PG8_ALIGN, PG8_SP2>(lds, g, S, E, TIDNOW);
        }
    }
    SEAM(4);
    if (IN(5)) { PH_IDS
        phase_rwkv_out(A, gtid, NGT);
        __syncthreads();
        for (int id = vcu; id < 128; id += G) {
            { pg8::Gemm g{MQh, MKh, 4 * M, 2048, 256}; pg8::ListSched S{id, 1 << 20, 128, 1, 0}; pg8::EpiSoftmax E{Pm, 0.0625f * 1.4426950408889634f};
              pg8::gemm_phase<pg8::EpiSoftmax, pg8::ListSched, false, PG8_SP2>(lds, g, S, E, TIDNOW); }
            __builtin_amdgcn_fence(__ATOMIC_SEQ_CST, "workgroup"); asm volatile("s_waitcnt vmcnt(0)" ::: "memory"); __syncthreads();
            { pg8::Gemm g{Pm, MVt, 4 * M, 2048, 256}; pg8::ListSched S{id, 1 << 20, 128, 1, 0}; pg8::EpiMemOut E{YC, Gt};
              pg8::gemm_phase<pg8::EpiMemOut, pg8::ListSched, false, PG8_SP2>(lds, g, S, E, TIDNOW); }
            __syncthreads();
        }
        const float* CUM = (const float*)(ws + WS_CUM);
        if (TIDNOW == 0) MISC[0] = atomicAdd(ctl + 64, 1u);
        __syncthreads(); int item = (int)MISC[0]; __syncthreads();
        while (item < 768) {
            unsigned nxt_item = 0u; const bool lead = (TIDNOW == 0);
            if (lead) nxt_item = __hip_atomic_fetch_add(ctl + 64, 1u, __ATOMIC_RELAXED, __HIP_MEMORY_SCOPE_AGENT);
            const int qb = 15 - item / 48, bh = item % 48;
            attn_body::attn_unit<8>(bh / NH, bh % NH, qb, (const attn_body::bf16*)FQ, (const attn_body::bf16*)FK, (const attn_body::bf16*)FV, (attn_body::bf16*)(YC + RW), (const attn_body::bf16*)(Gt + RW), CUM, (char*)lds_raw, TIDNOW);
            if (lead) MISC[0] = nxt_item;
            __syncthreads(); item = (int)MISC[0]; __syncthreads();
        }
    }
    SEAM(5);
    if (IN(6)) { PH_IDS pg8::Gemm g{YC, WoT, M, DMODEL, DMODEL}; pg8::StaticOrder S; S.init(M, DMODEL, G, bx); pg8::EpiF32 E{YO, DMODEL};
        pg8::gemm_phase<pg8::EpiF32, pg8::StaticOrder, PG8_ALIGN, PG8_SP2>(lds, g, S, E, TIDNOW); }
    SEAM(6);
    if (IN(7)) { PH_IDS phase_final(A, gw, NGW, lane); }
#undef IN
#undef SEAM
}

extern "C" void kernel_launch(void* const* d_in, const int* in_sizes, int n_in, void* d_out, int out_size, void* d_ws, size_t ws_size, hipStream_t stream) {
    static int grid = 0;
    if (grid == 0) {
        if (n_in != 19 || out_size != M * DMODEL || ws_size < WS_END) { fprintf(stderr, "kernel_launch: unexpected shapes (n_in %d out %d ws %zu)\n", n_in, out_size, ws_size); grid = -1; return; }
        int dev = 0, cus = 0, per_cu = 0;
        hipGetDevice(&dev); hipDeviceGetAttribute(&cus, hipDeviceAttributeMultiprocessorCount, dev);
        if (hipFuncSetAttribute((const void*)hybrid_fwd, hipFuncAttributeMaxDynamicSharedMemorySize, LDS_BYTES) != hipSuccess) { fprintf(stderr, "kernel_launch: hipFuncSetAttribute failed\n"); grid = -1; return; }
        if (hipOccupancyMaxActiveBlocksPerMultiprocessor(&per_cu, (const void*)hybrid_fwd, NWAVES * 64, LDS_BYTES) != hipSuccess || per_cu < 1) { fprintf(stderr, "kernel_launch: occupancy query says %d\n", per_cu); per_cu = 1; }
        (void)hipGetLastError();
        grid = cus * per_cu;
    }
    if (grid < 0) return;
    hipMemsetAsync((char*)d_ws + WS_CTL, 0, CTL_ZERO_BYTES, stream);
    Args a{};
    for (int i = 0; i < 19; ++i) a.in[i] = (const float*)d_in[i];
    a.out = (float*)d_out; a.ws = (unsigned char*)d_ws;
#if MK_SINGLE
    a.ph_lo = 0; a.ph_hi = NPHASE;
    void* args[] = {&a};
    hipError_t e = hipLaunchCooperativeKernel((const void*)hybrid_fwd, dim3(grid), dim3(NWAVES * 64), args, LDS_BYTES, stream);
    if (e != hipSuccess) fprintf(stderr, "cooperative launch failed: %s (grid %d)\n", hipGetErrorString(e), grid);
#else
    for (int p = 0; p < NPHASE; ++p) { a.ph_lo = p; a.ph_hi = p + 1; hipLaunchKernelGGL(hybrid_fwd, dim3(grid), dim3(NWAVES * 64), LDS_BYTES, stream, a);
#ifndef PROBE_FLAGS
#define PROBE_FLAGS 0
#endif
#ifdef PROBE_PHASES
        if ((PROBE_PHASES >> p) & 1) { hipMemsetAsync((char*)d_ws + WS_CTL, 0, CTL_ZERO_BYTES, stream); a.flags = PROBE_FLAGS; hipLaunchKernelGGL(hybrid_fwd, dim3(grid), dim3(NWAVES * 64), LDS_BYTES, stream, a); a.flags = 0; }
#endif
    }
#endif
}
```
